# Optimizing an MI355X kernel written in HIP

```python
import math
import jax, jax.numpy as jnp
from jax import lax
import numpy as np

D_MODEL = 2048
BATCH = 8
SEQ = 2048
DEPTH = 2

N_MIXERS = 2
N_A = (DEPTH + 1) // 2
N_B = DEPTH // 2
BLK = 128
WIN = 128
KEY_SPAN = BLK + 2 * WIN
A_DH = 64
A_HQ = D_MODEL // A_DH
A_KV = 4
A_G = A_HQ // A_KV
A_QKV = A_HQ * A_DH + 2 * A_KV * A_DH
B_DH = 128
B_H = D_MODEL // (2 * B_DH)
B_QKV = 3 * B_H * 2 * B_DH
D_FF = int(math.ceil(8 * D_MODEL / 3 / 256) * 256)
PLE_DIM = 256
EPS = 1e-6
NEG = -1e30

kernel_name = "hybrid_swa_sink_diffattn_encoder"


def rms_norm(x, g):
    xf = x.astype(jnp.float32)
    y = xf * lax.rsqrt(jnp.mean(xf * xf, axis=-1, keepdims=True) + EPS)
    return (y * g.astype(jnp.float32)).astype(x.dtype)


def alibi_slopes(n):
    return jnp.exp2(-8.0 * jnp.arange(1, n + 1, dtype=jnp.float32) / n)


def windowed_gqa_sink(h, w_qkv, q_gain, k_gain, sink, w_o):
    B, S, _ = h.shape
    nb = S // BLK
    qkv = h @ w_qkv
    nq = A_HQ * A_DH
    nk = A_KV * A_DH
    q = rms_norm(qkv[..., :nq].reshape(B, S, A_KV, A_G, A_DH), q_gain)
    k = rms_norm(qkv[..., nq:nq + nk].reshape(B, S, A_KV, A_DH), k_gain)
    v = qkv[..., nq + nk:].reshape(B, S, A_KV, A_DH)
    qb = q.reshape(B, nb, BLK, A_KV, A_G, A_DH).transpose(1, 0, 3, 4, 2, 5)
    pad = ((0, 0), (0, 0), (WIN, WIN), (0, 0))
    kp = jnp.pad(k.transpose(0, 2, 1, 3), pad)
    vp = jnp.pad(v.transpose(0, 2, 1, 3), pad)
    slopes = alibi_slopes(A_HQ).reshape(A_KV, A_G)
    sink_f = sink.astype(jnp.float32).reshape(A_KV, A_G)
    scale = A_DH ** -0.5

    def block(args):
        qblk, n = args
        start = n * BLK
        kb = lax.dynamic_slice_in_dim(kp, start, KEY_SPAN, axis=2)
        vb = lax.dynamic_slice_in_dim(vp, start, KEY_SPAN, axis=2)
        sc = jnp.einsum('bkgqd,bksd->bkgqs', qblk, kb).astype(jnp.float32) * scale
        t = start + jnp.arange(BLK)
        s = start - WIN + jnp.arange(KEY_SPAN)
        dist = jnp.abs(t[:, None] - s[None, :])
        valid = (dist <= WIN) & (s[None, :] >= 0) & (s[None, :] < S)
        sc = sc - slopes[:, :, None, None] * dist.astype(jnp.float32)
        sc = jnp.where(valid, sc, NEG)
        sink_col = jnp.broadcast_to(sink_f[None, :, :, None, None], sc.shape[:-1] + (1,))
        probs = jax.nn.softmax(jnp.concatenate([sc, sink_col], axis=-1), axis=-1)[..., :-1]
        return jnp.einsum('bkgqs,bksd->bkgqd', probs.astype(vb.dtype), vb)

    o = lax.map(block, (qb, jnp.arange(nb)))
    o = o.transpose(1, 0, 4, 2, 3, 5).reshape(B, S, A_HQ * A_DH)
    return o @ w_o


def diff_attention(h, w_qkv, q_gain, k_gain, lam_vecs, subln, w_o, lambda_init):
    B, S, _ = h.shape
    nb = S // BLK
    qkv = h @ w_qkv
    w = B_H * 2 * B_DH
    q = rms_norm(qkv[..., :w].reshape(B, S, B_H, 2, B_DH), q_gain)
    k = rms_norm(qkv[..., w:2 * w].reshape(B, S, B_H, 2, B_DH), k_gain)
    v = qkv[..., 2 * w:].reshape(B, S, B_H, 2 * B_DH)
    qb = q.reshape(B, nb, BLK, B_H, 2, B_DH).transpose(1, 0, 3, 4, 2, 5)
    kt = k.transpose(0, 2, 3, 1, 4)
    vt = v.transpose(0, 2, 1, 3)
    lv = lam_vecs.astype(jnp.float32)
    lam = jnp.exp(jnp.sum(lv[0] * lv[1])) - jnp.exp(jnp.sum(lv[2] * lv[3])) + lambda_init
    slopes = alibi_slopes(B_H)
    s_pos = jnp.arange(S)
    scale = B_DH ** -0.5

    def block(args):
        qblk, n = args
        sc = jnp.einsum('bhcqd,bhcsd->bhcqs', qblk, kt).astype(jnp.float32) * scale
        t = n * BLK + jnp.arange(BLK)
        dist = jnp.abs(t[:, None] - s_pos[None, :]).astype(jnp.float32)
        sc = sc - (slopes[:, None, None] * dist)[None, :, None]
        probs = jax.nn.softmax(sc, axis=-1)
        wts = probs[:, :, 0] - lam * probs[:, :, 1]
        return jnp.einsum('bhqs,bhse->bhqe', wts.astype(vt.dtype), vt)

    o = lax.map(block, (qb, jnp.arange(nb)))
    o = rms_norm(o, subln) * (1.0 - lambda_init)
    o = o.transpose(1, 0, 3, 2, 4).reshape(B, S, B_H * 2 * B_DH)
    return o @ w_o


def swiglu(h, w_in, w_out):
    gu = h @ w_in
    return (jax.nn.silu(gu[..., :D_FF]) * gu[..., D_FF:]) @ w_out


def setup_inputs(seed: int = 0) -> dict:
    key = jax.random.key(seed)
    ks = jax.random.split(key, 24)
    f32 = jnp.float32

    def nrm(k, shape, scale):
        return jax.random.normal(k, shape, f32) * scale

    def gain(k, shape):
        return 1.0 + 0.02 * jax.random.normal(k, shape, f32)

    return {
        "x": nrm(ks[0], (BATCH, SEQ, D_MODEL), 1.0),
        "p": nrm(ks[1], (DEPTH, BATCH, SEQ, PLE_DIM), 1.0),
        "attn_norm": gain(ks[2], (DEPTH, D_MODEL)),
        "ffn_norm": gain(ks[3], (DEPTH, D_MODEL)),
        "a_w_qkv": nrm(ks[4], (N_A, D_MODEL, A_QKV), D_MODEL ** -0.5),
        "a_q_norm": gain(ks[5], (N_A, A_DH)),
        "a_k_norm": gain(ks[6], (N_A, A_DH)),
        "a_sink": nrm(ks[7], (N_A, A_HQ), 0.5),
        "a_w_o": nrm(ks[8], (N_A, A_HQ * A_DH, D_MODEL), (A_HQ * A_DH) ** -0.5),
        "b_w_qkv": nrm(ks[9], (N_B, D_MODEL, B_QKV), D_MODEL ** -0.5),
        "b_q_norm": gain(ks[10], (N_B, B_DH)),
        "b_k_norm": gain(ks[11], (N_B, B_DH)),
        "b_lambda": nrm(ks[12], (N_B, 4, B_DH), 0.1),
        "b_subln": gain(ks[13], (N_B, 2 * B_DH)),
        "b_w_o": nrm(ks[14], (N_B, B_H * 2 * B_DH, D_MODEL), (B_H * 2 * B_DH) ** -0.5),
        "w_ffn_in": nrm(ks[15], (DEPTH, D_MODEL, 2 * D_FF), D_MODEL ** -0.5),
        "w_ffn_out": nrm(ks[16], (DEPTH, D_FF, D_MODEL), D_FF ** -0.5),
        "ple_w_proj": nrm(ks[17], (DEPTH, PLE_DIM, D_MODEL), PLE_DIM ** -0.5),
        "ple_post_norm": gain(ks[18], (DEPTH, D_MODEL)),
        "ple_gate_norm": gain(ks[19], (DEPTH, D_MODEL)),
        "ple_w_gate": nrm(ks[20], (DEPTH, D_MODEL, D_MODEL), D_MODEL ** -0.5),
    }


def reference(x, p, attn_norm, ffn_norm, a_w_qkv, a_q_norm, a_k_norm, a_sink, a_w_o,
              b_w_qkv, b_q_norm, b_k_norm, b_lambda, b_subln, b_w_o,
              w_ffn_in, w_ffn_out, ple_w_proj, ple_post_norm, ple_gate_norm, ple_w_gate):
    h = x
    for i in range(DEPTH):
        hn = rms_norm(h, attn_norm[i])
        j = i // N_MIXERS
        if i % N_MIXERS == 0:
            mix = windowed_gqa_sink(hn, a_w_qkv[j], a_q_norm[j], a_k_norm[j], a_sink[j], a_w_o[j])
        else:
            lambda_init = 0.8 - 0.6 * math.exp(-0.3 * i)
            mix = diff_attention(hn, b_w_qkv[j], b_q_norm[j], b_k_norm[j], b_lambda[j],
                                 b_subln[j], b_w_o[j], lambda_init)
        h = h + mix
        h = h + swiglu(rms_norm(h, ffn_norm[i]), w_ffn_in[i], w_ffn_out[i])
        gate = jax.nn.sigmoid(rms_norm(h, ple_gate_norm[i]) @ ple_w_gate[i])
        h = h + rms_norm(p[i] @ ple_w_proj[i], ple_post_norm[i]) * gate
    return h
```

```cpp
#include <hip/hip_runtime.h>
#include <hip/hip_cooperative_groups.h>
#include <cstdio>
#include <cstdint>
namespace cg = cooperative_groups;
constexpr int LDS_WTAB_OFF = 156 * 1024 - 64 - 256;
__device__ __forceinline__ unsigned hw_wave_key() { return __builtin_amdgcn_s_getreg((5 << 11) | 4) & 63u; }
__device__ __forceinline__ int tid_now() {
    const int w = ((volatile __attribute__((address_space(3))) int*)(LDS_WTAB_OFF))[hw_wave_key()];
    int lane; asm volatile("v_mbcnt_lo_u32_b32 %0, -1, 0\n\tv_mbcnt_hi_u32_b32 %0, -1, %0" : "=v"(lane));
    return __builtin_amdgcn_readfirstlane(w) * 64 + lane;
}
#define TIDX tid_now()
namespace pg8 {
#define PG8_LAS __attribute__((address_space(3)))
typedef unsigned short bf16_t;
typedef short bf16x8 __attribute__((ext_vector_type(8)));
typedef float f32x4 __attribute__((ext_vector_type(4)));
typedef unsigned u32x4 __attribute__((ext_vector_type(4)));
constexpr int BM = 256, BK = 64, HALF = 128, HTB = HALF * BK * 2  , STAGE_BYTES = 8 * HTB, NXCD = 8, WGM = 8;

__host__ __device__ __forceinline__ int lds_byte(int r, int c) { const int st = (r >> 4) * 2 + (c >> 5), rr = r & 15, cc = c & 31, ob = rr * 64 + cc * 2; return st * 1024 + (ob ^ (((ob >> 9) & 1) << 5)); }
__host__ __device__ __forceinline__ void stage_rc(int b, int& R, int& C) { const int st = b / 1024, sb = b % 1024, swz = sb ^ (((sb >> 9) & 1) << 5); R = (st >> 1) * 16 + swz / 64; C = (st & 1) * 32 + (swz % 64) / 2; }
__host__ __device__ __forceinline__ int perm32(int rho) { const int n = rho >> 4, i = rho & 15; return 8 * (i >> 2) + 4 * n + (i & 3); }

struct Unit { int pm, pn; };
struct Gemm { const bf16_t* A; const bf16_t* Bt; int M, N, K; };

struct StaticOrder {
    int nM, nN, nwg, G, c;
    __host__ __device__ void init(int M, int N, int G_, int c_) { nM = M / BM; nN = N / BM; nwg = nM * nN; G = G_; c = c_; }
    __host__ __device__ bool next(int i, Unit& u) const {
        const long L = (long)i * G + c; if (L >= nwg) return false;
        int wgid = (int)L; { const int q = nwg / NXCD, r = nwg % NXCD, xcd = wgid % NXCD, off = wgid / NXCD; wgid = (xcd < r ? xcd * (q + 1) : r * (q + 1) + (xcd - r) * q) + off; }
        const int nig = WGM * nN, gid = wgid / nig, fm = gid * WGM, gsz = (nM - fm) < WGM ? (nM - fm) : WGM;
        u.pm = fm + ((wgid % nig) % gsz); u.pn = (wgid % nig) / gsz; return true;
    }
    __device__ __forceinline__ void a_ready(const Unit&) const {}
    __device__ __forceinline__ void done(const Unit&) const {}
};

__device__ __forceinline__ unsigned cvt_pk_bf16(float lo, float hi) { unsigned r; asm volatile("v_cvt_pk_bf16_f32 %0, %1, %2" : "=v"(r) : "v"(lo), "v"(hi)); return r; }
typedef float f32x2 __attribute__((ext_vector_type(2)));
typedef unsigned u32x2 __attribute__((ext_vector_type(2)));
constexpr float RMS_EPS = 1e-6f;
typedef unsigned long long sq_t;
__device__ __forceinline__ float sq2f(sq_t v) { return (float)v * (1.0f / 1048576.0f); }
__device__ __forceinline__ sq_t f2sq(float s) { return (sq_t)(s * 1048576.0f + 0.5f); }
constexpr float LOG2E_F = 1.4426950408889634f;
__device__ __forceinline__ float rs_from_ssq(float ssq, float inv_n) { return __builtin_amdgcn_rsqf(ssq * inv_n + RMS_EPS); }
__device__ __forceinline__ float sq4(const f32x4 v) { return (v[0] * v[0] + v[1] * v[1]) + (v[2] * v[2] + v[3] * v[3]); }
__device__ __forceinline__ u32x4 pack8(const f32x4 a, const f32x4 b) { u32x4 w; w.x = cvt_pk_bf16(a[0], a[1]); w.y = cvt_pk_bf16(a[2], a[3]); w.z = cvt_pk_bf16(b[0], b[1]); w.w = cvt_pk_bf16(b[2], b[3]); return w; }
__device__ __forceinline__ float bflo(unsigned w) { return __uint_as_float(w << 16); }
__device__ __forceinline__ float bfhi(unsigned w) { return __uint_as_float(w & 0xffff0000u); }
__device__ __forceinline__ float sigmoid_f(float x) { return __builtin_amdgcn_rcpf(1.0f + __builtin_amdgcn_exp2f(-x * LOG2E_F)); }

struct EpiQK {
    static constexpr bool PERM = true, AFTER_DRAIN = false;
    bf16_t* O; int ldc; const sq_t* ssq_in; const float* gq; const float* gk; int hd; float qscale; PG8_LAS float* xq;
    __device__ __forceinline__ void operator()(const f32x4 (&acc)[2][2][4][2], const Unit& u, int wr, int wc, int fr, int fq) const {
        const int row0 = u.pm * BM + wr * 64 + fr, col0 = u.pn * BM + wc * 32 + 8 * fq;
        const bool isq = u.pn * BM < 2048; const float* gp = isq ? gq : gk; const float fold = isq ? qscale : 1.0f;
#pragma unroll
        for (int ai = 0; ai < 2; ++ai)
#pragma unroll
            for (int m = 0; m < 4; ++m) { const int lrow = ai * HALF + wr * 64 + m * 16 + fr; const float rs = rs_from_ssq(sq2f(ssq_in[u.pm * BM + lrow]), 1.0f / 2048.0f);
#pragma unroll
                for (int bj = 0; bj < 2; ++bj) { const f32x4 v0 = acc[ai][bj][m][0] * rs, v1 = acc[ai][bj][m][1] * rs;
                    float s = sq4(v0) + sq4(v1); s += __shfl_xor(s, 16); s += __shfl_xor(s, 32);
                    if (fq == 0) xq[(lrow * 2 + bj) * 4 + wc] = s; } }
#ifndef NOXCH
        asm volatile("s_waitcnt lgkmcnt(0)" ::: "memory"); __builtin_amdgcn_s_barrier(); asm volatile("" ::: "memory");
#endif
        const float inv_hd = hd == 128 ? (1.0f / 128.0f) : (1.0f / 64.0f);
#pragma unroll
        for (int ai = 0; ai < 2; ++ai)
#pragma unroll
            for (int m = 0; m < 4; ++m) { const int lrow = ai * HALF + wr * 64 + m * 16 + fr; const int row = u.pm * BM + lrow; const float rsrow = rs_from_ssq(sq2f(ssq_in[row]), 1.0f / 2048.0f) * fold;
#pragma unroll
                for (int bj = 0; bj < 2; ++bj) { const f32x4 pr = *(const PG8_LAS f32x4*)(xq + (lrow * 2 + bj) * 4);
                    const int d0 = (bj * HALF + wc * 32 + 8 * fq) & (hd - 1); const f32x4 g0 = *(const f32x4*)(gp + d0), g1 = *(const f32x4*)(gp + d0 + 4);
#ifdef NOXCH
                    const float tot = 64.0f; (void)pr;
#else
                    const float tot = hd == 128 ? ((pr[0] + pr[1]) + (pr[2] + pr[3])) : ((wc & 2) ? (pr[2] + pr[3]) : (pr[0] + pr[1]));
#endif
                    const float rn = __builtin_amdgcn_rsqf(tot * inv_hd + RMS_EPS) * rsrow;
                    *(u32x4*)(O + (size_t)row * ldc + col0 + bj * HALF) = pack8(acc[ai][bj][m][0] * rn * g0, acc[ai][bj][m][1] * rn * g1); }
                asm volatile("" ::: "memory"); }
    }
};
struct EpiVt {
    static constexpr bool PERM = true, AFTER_DRAIN = false;
    bf16_t* O; int ldc; const sq_t* ssq_in;
    __device__ __forceinline__ void operator()(const f32x4 (&acc)[2][2][4][2], const Unit& u, int wr, int wc, int fr, int fq) const {
        const int row0 = u.pm * BM + wr * 64 + fr, col0 = u.pn * BM + wc * 32 + 8 * fq;
        f32x4 rs[2][2];
#pragma unroll
        for (int bj = 0; bj < 2; ++bj)
#pragma unroll
            for (int n = 0; n < 2; ++n) { const sq_t* q = ssq_in + col0 + bj * HALF + 4 * n;
                rs[bj][n] = (f32x4){rs_from_ssq(sq2f(q[0]), 1.0f / 2048.0f), rs_from_ssq(sq2f(q[1]), 1.0f / 2048.0f), rs_from_ssq(sq2f(q[2]), 1.0f / 2048.0f), rs_from_ssq(sq2f(q[3]), 1.0f / 2048.0f)}; }
#pragma unroll
        for (int ai = 0; ai < 2; ++ai)
#pragma unroll
            for (int m = 0; m < 4; ++m) { const int row = row0 + ai * HALF + m * 16;
#pragma unroll
                for (int bj = 0; bj < 2; ++bj) *(u32x4*)(O + (size_t)row * ldc + col0 + bj * HALF) = pack8(acc[ai][bj][m][0] * rs[bj][0], acc[ai][bj][m][1] * rs[bj][1]); }
    }
};
struct EpiRes {
    static constexpr bool PERM = true, AFTER_DRAIN = false;
    const bf16_t* hin; bf16_t* hb; sq_t* ssq_out;
    __device__ __forceinline__ void operator()(const f32x4 (&acc)[2][2][4][2], const Unit& u, int wr, int wc, int fr, int fq) const {
        const int row0 = u.pm * BM + wr * 64 + fr, col0 = u.pn * BM + wc * 32 + 8 * fq;
#pragma unroll
        for (int ai = 0; ai < 2; ++ai)
#pragma unroll
            for (int m = 0; m < 4; ++m) { const int row = row0 + ai * HALF + m * 16; const size_t off = (size_t)row * 2048 + col0; float s = 0.f;
#pragma unroll
                for (int bj = 0; bj < 2; ++bj) { const u32x4 hr = *(const u32x4*)(hin + off + bj * HALF);
                    const f32x4 v0 = acc[ai][bj][m][0] + (f32x4){bflo(hr.x), bfhi(hr.x), bflo(hr.y), bfhi(hr.y)}, v1 = acc[ai][bj][m][1] + (f32x4){bflo(hr.z), bfhi(hr.z), bflo(hr.w), bfhi(hr.w)};
                    *(u32x4*)(hb + off + bj * HALF) = pack8(v0, v1); s += sq4(v0) + sq4(v1); }
                s += __shfl_xor(s, 16); s += __shfl_xor(s, 32);
                if (fq == 0) atomicAdd(ssq_out + row, f2sq(s)); }
    }
};
struct EpiSwiGLU {
    static constexpr bool PERM = true, AFTER_DRAIN = false;
    bf16_t* O; const sq_t* ssq_in;
    __device__ __forceinline__ void operator()(const f32x4 (&acc)[2][2][4][2], const Unit& u, int wr, int wc, int fr, int fq) const {
        const int row0 = u.pm * BM + wr * 64 + fr, col0 = u.pn * HALF + wc * 32 + 8 * fq;
#pragma unroll
        for (int ai = 0; ai < 2; ++ai)
#pragma unroll
            for (int m = 0; m < 4; ++m) { const int row = row0 + ai * HALF + m * 16; const float rs = rs_from_ssq(sq2f(ssq_in[row]), 1.0f / 2048.0f);
                f32x4 o[2];
#pragma unroll
                for (int n = 0; n < 2; ++n) { const f32x4 g = acc[ai][0][m][n] * rs, uu = acc[ai][1][m][n] * rs;
#pragma unroll
                    for (int e = 0; e < 4; ++e) o[n][e] = g[e] * sigmoid_f(g[e]) * uu[e]; }
                *(u32x4*)(O + (size_t)row * 5632 + col0) = pack8(o[0], o[1]); }
    }
};
struct EpiPP {
    static constexpr bool PERM = true, AFTER_DRAIN = false;
    bf16_t* O; sq_t* ssq_out;
    __device__ __forceinline__ void operator()(const f32x4 (&acc)[2][2][4][2], const Unit& u, int wr, int wc, int fr, int fq) const {
        const int row0 = u.pm * BM + wr * 64 + fr, col0 = u.pn * BM + wc * 32 + 8 * fq;
#pragma unroll
        for (int ai = 0; ai < 2; ++ai)
#pragma unroll
            for (int m = 0; m < 4; ++m) { const int row = row0 + ai * HALF + m * 16; const size_t off = (size_t)row * 2048 + col0; float s = 0.f;
#pragma unroll
                for (int bj = 0; bj < 2; ++bj) { *(u32x4*)(O + off + bj * HALF) = pack8(acc[ai][bj][m][0], acc[ai][bj][m][1]); s += sq4(acc[ai][bj][m][0]) + sq4(acc[ai][bj][m][1]); }
                s += __shfl_xor(s, 16); s += __shfl_xor(s, 32);
                if (fq == 0) atomicAdd(ssq_out + row, f2sq(s)); }
    }
};
struct EpiPLE {
    static constexpr bool PERM = true, AFTER_DRAIN = false;
    const bf16_t* hin; float* hout; bf16_t* hb; sq_t* ssq_out; const sq_t* ssq_h; const sq_t* ssq_pp; const bf16_t* PP; const float* post;
    __device__ __forceinline__ void operator()(const f32x4 (&acc)[2][2][4][2], const Unit& u, int wr, int wc, int fr, int fq) const {
        const int row0 = u.pm * BM + wr * 64 + fr, col0 = u.pn * BM + wc * 32 + 8 * fq;
        f32x4 pw[2][2];
#pragma unroll
        for (int bj = 0; bj < 2; ++bj)
#pragma unroll
            for (int n = 0; n < 2; ++n) pw[bj][n] = *(const f32x4*)(post + col0 + bj * HALF + 4 * n);
#pragma unroll
        for (int ai = 0; ai < 2; ++ai)
#pragma unroll
            for (int m = 0; m < 4; ++m) { const int row = row0 + ai * HALF + m * 16; const size_t off = (size_t)row * 2048 + col0; float s = 0.f;
                const float rh = rs_from_ssq(sq2f(ssq_h[row]), 1.0f / 2048.0f), rp = rs_from_ssq(sq2f(ssq_pp[row]), 1.0f / 2048.0f);
#pragma unroll
                for (int bj = 0; bj < 2; ++bj) { const u32x4 hr = *(const u32x4*)(hin + off + bj * HALF);
                    const f32x4 h0 = (f32x4){bflo(hr.x), bfhi(hr.x), bflo(hr.y), bfhi(hr.y)}, h1 = (f32x4){bflo(hr.z), bfhi(hr.z), bflo(hr.w), bfhi(hr.w)};
                    const u32x4 pr = *(const u32x4*)(PP + off + bj * HALF);
                    const f32x4 p0 = (f32x4){bflo(pr.x), bfhi(pr.x), bflo(pr.y), bfhi(pr.y)}, p1 = (f32x4){bflo(pr.z), bfhi(pr.z), bflo(pr.w), bfhi(pr.w)};
                    f32x4 v0, v1;
#pragma unroll
                    for (int e = 0; e < 4; ++e) { v0[e] = h0[e] + p0[e] * rp * pw[bj][0][e] * sigmoid_f(acc[ai][bj][m][0][e] * rh); v1[e] = h1[e] + p1[e] * rp * pw[bj][1][e] * sigmoid_f(acc[ai][bj][m][1][e] * rh); }
                    if (hout) { *(f32x4*)(hout + off + bj * HALF) = v0; *(f32x4*)(hout + off + bj * HALF + 4) = v1; }
                    if (hb) { *(u32x4*)(hb + off + bj * HALF) = pack8(v0, v1); s += sq4(v0) + sq4(v1); } }
                if (hb) { s += __shfl_xor(s, 16); s += __shfl_xor(s, 32); if (fq == 0) atomicAdd(ssq_out + row, f2sq(s)); } }
    }
};
template <class Epi, class Sched, bool ALIGN_EPI = false, bool SP2 = false>
__device__ __forceinline__ void gemm_phase(PG8_LAS unsigned char* lds, const Gemm g, const Sched& S, const Epi& E) {
    int tid_ = TIDX; asm volatile("" : "+v"(tid_));
    const int tid = tid_, wid = __builtin_amdgcn_readfirstlane(tid >> 6), lane = tid & 63, wr = wid >> 2, wc = wid & 3, fr = lane & 15, fq = lane >> 4;
    const int K = g.K, nt = K / BK;
    unsigned voffA[2], voffB[2];
#pragma unroll
    for (int i = 0; i < 2; ++i) { int R, C; stage_rc(tid * 16 + i * 8192, R, C); const int Rb = Epi::PERM ? ((R & ~31) + perm32(R & 31)) : R;
        voffA[i] = (unsigned)(R * K + C) * 2u; voffB[i] = (unsigned)(Rb * K + C) * 2u; }
    const size_t kstep = (size_t)(BK * 2);
    const size_t hstep = (size_t)HALF * K * 2;
    const size_t tstep = 2 * hstep;
    const unsigned ldsw = (unsigned)wid * 1024u;
    const int aoff = lds_byte(wr * 64 + fr, fq * 8), boff = lds_byte(wc * 32 + fr, fq * 8);
#define PG8_SA(b, h) (((b) * 2 + (h)) * HTB)
#define PG8_SB(b, h) ((4 + (b) * 2 + (h)) * HTB)
#define PG8_STAGE(bufoff, gbase, voff) do { _Pragma("unroll") for (int _i = 0; _i < 2; ++_i) \
        __builtin_amdgcn_global_load_lds((const unsigned*)((const char*)(gbase) + (voff)[_i]), (PG8_LAS unsigned*)(lds + (bufoff) + ldsw + _i * 8192), 16, 0, 0); } while (0)
#define PG8_LDA(dst, b, h) do { _Pragma("unroll") for (int m = 0; m < 4; ++m) _Pragma("unroll") for (int k = 0; k < 2; ++k) dst[m][k] = *(const PG8_LAS bf16x8*)(lds + PG8_SA(b, h) + aoff + m * 2048 + k * 1024); } while (0)
#define PG8_LDB(dst, b, h) do { _Pragma("unroll") for (int n = 0; n < 2; ++n) _Pragma("unroll") for (int k = 0; k < 2; ++k) dst[n][k] = *(const PG8_LAS bf16x8*)(lds + PG8_SB(b, h) + boff + n * 2048 + k * 1024); } while (0)
#define PG8_MMA(ai, bj, At, Bt) do { __builtin_amdgcn_s_setprio(1); _Pragma("unroll") for (int m = 0; m < 4; ++m) _Pragma("unroll") for (int n = 0; n < 2; ++n) _Pragma("unroll") for (int k = 0; k < 2; ++k) \
        acc[ai][bj][m][n] = __builtin_amdgcn_mfma_f32_16x16x32_bf16(Bt[n][k], At[m][k], acc[ai][bj][m][n], 0, 0, 0); __builtin_amdgcn_s_setprio(0); } while (0)
#define PG8_WAIT_V(n) asm volatile("s_waitcnt vmcnt(" #n ")" ::: "memory")
#define PG8_WAIT_L(n) asm volatile("s_waitcnt lgkmcnt(" #n ")" ::: "memory")
#define PG8_BAR __builtin_amdgcn_s_barrier()
#define PG8_SCHED __builtin_amdgcn_sched_barrier(0)
    Unit cur, nxt; int ui = 0;
    if (!S.next(0, cur)) return;
    f32x4 acc[2][2][4][2];
#pragma unroll
    for (int a = 0; a < 2; ++a)
#pragma unroll
        for (int b = 0; b < 2; ++b)
#pragma unroll
            for (int m = 0; m < 4; ++m)
#pragma unroll
                for (int n = 0; n < 2; ++n) acc[a][b][m][n] = (f32x4){0.f, 0.f, 0.f, 0.f};
    bf16x8 At[4][2], B0[2][2], B1[2][2];
    const char* cA = (const char*)g.A + (size_t)cur.pm * tstep; const char* cB = (const char*)g.Bt + (size_t)cur.pn * tstep;
    S.a_ready(cur);
    if constexpr (SP2) {
        PG8_STAGE(PG8_SB(0, 0), cB, voffB); PG8_STAGE(PG8_SB(0, 1), cB + hstep, voffB); PG8_STAGE(PG8_SA(0, 0), cA, voffA); PG8_STAGE(PG8_SA(0, 1), cA + hstep, voffA);
        if (wr == 1) PG8_BAR;
        PG8_WAIT_V(2); PG8_BAR;
        PG8_STAGE(PG8_SB(1, 0), cB + kstep, voffB); PG8_STAGE(PG8_SA(1, 0), cA + kstep, voffA); PG8_STAGE(PG8_SB(1, 1), cB + hstep + kstep, voffB);
        PG8_WAIT_V(6); PG8_BAR;
    } else {
        PG8_STAGE(PG8_SB(0, 0), cB, voffB); PG8_STAGE(PG8_SA(0, 0), cA, voffA); PG8_STAGE(PG8_SB(0, 1), cB + hstep, voffB); PG8_STAGE(PG8_SA(0, 1), cA + hstep, voffA);
        if (wr == 1) PG8_BAR;
        PG8_WAIT_V(4); PG8_BAR;
        PG8_STAGE(PG8_SB(1, 0), cB + kstep, voffB); PG8_STAGE(PG8_SA(1, 0), cA + kstep, voffA); PG8_STAGE(PG8_SB(1, 1), cB + hstep + kstep, voffB);
        PG8_WAIT_V(6); PG8_BAR;
    }
    for (;;) {
        const bool has_next = S.next(ui + 1, nxt);
        const char* nA = has_next ? (const char*)g.A + (size_t)nxt.pm * tstep : cA; const char* nB = has_next ? (const char*)g.Bt + (size_t)nxt.pn * tstep : cB;
        for (int t = 0; t < nt; t += 2) {
            const bool last = (t == nt - 2);
            const char* a1 = cA + (size_t)(t + 1) * kstep;
            const char* a2 = last ? nA : cA + (size_t)(t + 2) * kstep; const char* b2 = last ? nB : cB + (size_t)(t + 2) * kstep;
            const char* a3 = a2 + kstep; const char* b3 = b2 + kstep;
            if (last && has_next) S.a_ready(nxt);
            if constexpr (SP2) {
            PG8_LDB(B0, 0, 0); PG8_LDB(B1, 0, 1); PG8_SCHED; PG8_LDA(At, 0, 0); PG8_STAGE(PG8_SA(1, 1), a1 + hstep, voffA);
            PG8_WAIT_V(8); PG8_WAIT_L(0); PG8_BAR; PG8_MMA(0, 0, At, B0); PG8_MMA(0, 1, At, B1); PG8_BAR; PG8_SCHED;
            PG8_LDA(At, 0, 1); PG8_STAGE(PG8_SB(0, 0), b2, voffB); PG8_STAGE(PG8_SB(0, 1), b2 + hstep, voffB); PG8_STAGE(PG8_SA(0, 0), a2, voffA);
            PG8_WAIT_V(8); PG8_WAIT_L(0); PG8_BAR; PG8_MMA(1, 0, At, B0); PG8_MMA(1, 1, At, B1); PG8_BAR; PG8_SCHED;
            PG8_LDB(B0, 1, 0); PG8_LDB(B1, 1, 1); PG8_SCHED; PG8_LDA(At, 1, 0); PG8_STAGE(PG8_SA(0, 1), a2 + hstep, voffA);
            PG8_WAIT_V(8); PG8_WAIT_L(0); PG8_BAR; PG8_MMA(0, 0, At, B0); PG8_MMA(0, 1, At, B1); PG8_BAR; PG8_SCHED;
            PG8_LDA(At, 1, 1); PG8_STAGE(PG8_SB(1, 0), b3, voffB); PG8_STAGE(PG8_SB(1, 1), b3 + hstep, voffB); PG8_STAGE(PG8_SA(1, 0), a3, voffA);
            PG8_WAIT_V(8); PG8_WAIT_L(0); PG8_BAR; PG8_MMA(1, 0, At, B0); PG8_MMA(1, 1, At, B1); PG8_BAR; PG8_SCHED;
            } else {
            PG8_LDB(B0, 0, 0); PG8_SCHED; PG8_LDA(At, 0, 0); PG8_STAGE(PG8_SA(1, 1), a1 + hstep, voffA);
            PG8_WAIT_L(8); PG8_BAR; PG8_WAIT_L(0); PG8_MMA(0, 0, At, B0); PG8_BAR; PG8_SCHED;
            PG8_LDB(B1, 0, 1); PG8_STAGE(PG8_SB(0, 0), b2, voffB);
            PG8_BAR; PG8_WAIT_L(0); PG8_MMA(0, 1, At, B1); PG8_BAR;
            PG8_LDA(At, 0, 1); PG8_STAGE(PG8_SA(0, 0), a2, voffA);
            PG8_BAR; PG8_WAIT_L(0); PG8_MMA(1, 0, At, B0); PG8_BAR; PG8_SCHED;
            PG8_STAGE(PG8_SB(0, 1), b2 + hstep, voffB);
            PG8_WAIT_V(6); PG8_BAR; PG8_MMA(1, 1, At, B1); PG8_BAR;
            PG8_LDB(B0, 1, 0); PG8_SCHED; PG8_LDA(At, 1, 0); PG8_STAGE(PG8_SA(0, 1), a2 + hstep, voffA);
            PG8_WAIT_L(8); PG8_BAR; PG8_WAIT_L(0); PG8_MMA(0, 0, At, B0); PG8_BAR; PG8_SCHED;
            PG8_LDB(B1, 1, 1); PG8_STAGE(PG8_SB(1, 0), b3, voffB);
            PG8_BAR; PG8_WAIT_L(0); PG8_MMA(0, 1, At, B1); PG8_BAR;
            PG8_LDA(At, 1, 1); PG8_STAGE(PG8_SA(1, 0), a3, voffA);
            PG8_BAR; PG8_WAIT_L(0); PG8_MMA(1, 0, At, B0); PG8_BAR; PG8_SCHED;
            PG8_STAGE(PG8_SB(1, 1), b3 + hstep, voffB);
            PG8_WAIT_V(6); PG8_BAR; PG8_MMA(1, 1, At, B1); PG8_BAR;
            }
        }
        if constexpr (ALIGN_EPI) { if (wr == 0) PG8_BAR; }
        if constexpr (!Epi::AFTER_DRAIN) { E(acc, cur, wr, wc, fr, fq); S.done(cur); }
        if (!has_next) break;
#pragma unroll
        for (int a = 0; a < 2; ++a)
#pragma unroll
            for (int b = 0; b < 2; ++b)
#pragma unroll
                for (int m = 0; m < 4; ++m)
#pragma unroll
                    for (int n = 0; n < 2; ++n) acc[a][b][m][n] = (f32x4){0.f, 0.f, 0.f, 0.f};
        cur = nxt; cA = nA; cB = nB; ++ui;
        if constexpr (ALIGN_EPI) { if (wr == 1) PG8_BAR; }
    }
    PG8_WAIT_V(0);
    if constexpr (!ALIGN_EPI) { if (wr == 0) PG8_BAR; }
    PG8_BAR;
    if constexpr (Epi::AFTER_DRAIN) { E.fused(acc, cur, wr, wc, fr, fq, lds, wid, lane); S.done(cur); }
#undef PG8_SA
#undef PG8_SB
#undef PG8_STAGE
#undef PG8_LDA
#undef PG8_LDB
#undef PG8_MMA
#undef PG8_WAIT_V
#undef PG8_WAIT_L
#undef PG8_BAR
#undef PG8_SCHED
}
}

#define LAS __attribute__((address_space(3)))
typedef unsigned short bf16;
typedef unsigned u32x4 __attribute__((ext_vector_type(4)));
typedef unsigned u32x2 __attribute__((ext_vector_type(2)));
typedef float f32x4 __attribute__((ext_vector_type(4)));
typedef float f32x16 __attribute__((ext_vector_type(16)));
typedef short bf16x8 __attribute__((ext_vector_type(8)));
constexpr float LOG2E = 1.4426950408889634f;
constexpr float EPS = 1e-6f;
__device__ __forceinline__ float wave_sum(float v) {
#pragma unroll
    for (int o = 1; o < 64; o <<= 1) v += __shfl_xor(v, o);
    return v;
}
__device__ __forceinline__ float wave_max(float v) {
#pragma unroll
    for (int o = 1; o < 64; o <<= 1) v = fmaxf(v, __shfl_xor(v, o));
    return v;
}
__device__ __forceinline__ unsigned pk2(float lo, float hi) { return pg8::cvt_pk_bf16(lo, hi); }
__device__ __forceinline__ float bflo(unsigned w) { return __uint_as_float(w << 16); }
__device__ __forceinline__ float bfhi(unsigned w) { return __uint_as_float(w & 0xffff0000u); }
__device__ __forceinline__ int swap23(int r) { return (r & ~12) | ((r & 4) << 1) | ((r & 8) >> 1); }
__device__ __forceinline__ bf16x8 scale_frag(const u32x4 raw, const float s, const LAS float* gg) {
    const f32x4 g0 = *(const LAS f32x4*)gg, g1 = *(const LAS f32x4*)(gg + 4);
    u32x4 w;
    w.x = pk2(bflo(raw.x) * s * g0[0], bfhi(raw.x) * s * g0[1]); w.y = pk2(bflo(raw.y) * s * g0[2], bfhi(raw.y) * s * g0[3]);
    w.z = pk2(bflo(raw.z) * s * g1[0], bfhi(raw.z) * s * g1[1]); w.w = pk2(bflo(raw.w) * s * g1[2], bfhi(raw.w) * s * g1[3]);
    return __builtin_bit_cast(bf16x8, w);
}
#define MFMA32(a, b, c) __builtin_amdgcn_mfma_f32_32x32x16_bf16((a), (b), (c), 0, 0, 0)

#define XB_TMO      128
#define XB_XCNT(j)  (256  + 64 * (j))
#define XB_XSUB(j)  (1280 + 64 * (j))
#define XB_XGEN(j)  (2304 + 64 * (j))
#define XB_TOP      3328
#define XB_TOPGEN   3392
#define XCD_BAR_WORDS 3456
#define XB_SPIN_CAP (1u << 18)

__device__ __forceinline__ unsigned xb_ld(unsigned* p)              { return __hip_atomic_load(p, __ATOMIC_RELAXED, __HIP_MEMORY_SCOPE_AGENT); }
__device__ __forceinline__ unsigned xb_add(unsigned* p, unsigned v) { return __hip_atomic_fetch_add(p, v, __ATOMIC_RELAXED, __HIP_MEMORY_SCOPE_AGENT); }
__device__ __forceinline__ unsigned xb_xcc_id() { return (unsigned)__builtin_amdgcn_s_getreg((3 << 11) | 20) & 0xFu; }
#define XB_SPIN(cond, bar) do { unsigned _sp = 0; while (cond) { __builtin_amdgcn_s_sleep(1); \
    if ((++_sp & 255u) == 0u) { if (xb_ld(&(bar)[XB_TMO])) break; if (_sp > XB_SPIN_CAP) { atomicAdd(&(bar)[XB_TMO], 1u); break; } } } } while (0)

struct XcdBarrier {
    unsigned* bar; unsigned x;
    volatile LAS unsigned* st;
};

__device__ __forceinline__ XcdBarrier xcd_barrier_post(unsigned* bar, volatile LAS unsigned* st) {
    XcdBarrier b; b.bar = bar; b.x = xb_xcc_id(); b.st = st;
    if (TIDX == 0) (void)xb_add(&bar[XB_XCNT(b.x)], 1u);
    return b;
}
__device__ __forceinline__ void xcd_barrier_complete(unsigned* bar, unsigned x, unsigned& nloc, unsigned& nx) {
    const unsigned G = gridDim.x * gridDim.y * gridDim.z;
    unsigned sum, cnt, mine, sp = 0u;
    for (;;) {
        sum = 0u; cnt = 0u; mine = 0u;
#pragma unroll
        for (unsigned j = 0; j < 16; ++j) { const unsigned c = xb_ld(&bar[XB_XCNT(j)]); sum += c; cnt += (c > 0u) ? 1u : 0u; mine = (j == x) ? c : mine; }
        if (sum == G) break;
        __builtin_amdgcn_s_sleep(1);
        if ((++sp & 255u) == 0u) { if (xb_ld(&bar[XB_TMO])) break; if (sp > XB_SPIN_CAP) { atomicAdd(&bar[XB_TMO], 1u); break; } }
    }
    nloc = mine > 0u ? mine : 1u; nx = cnt > 0u ? cnt : 1u;
}

__device__ __forceinline__ void xcd_barrier(const XcdBarrier& b) {
    asm volatile("s_waitcnt vmcnt(0)" ::: "memory");
    __syncthreads();
    if (TIDX == 0) {
        unsigned* bar = b.bar;
        __builtin_amdgcn_s_waitcnt(0);
        unsigned nloc = b.st[0], nx = b.st[1];
        if (nloc == 0u) { xcd_barrier_complete(bar, b.x, nloc, nx); b.st[0] = nloc; b.st[1] = nx; }
        const unsigned old = xb_add(&bar[XB_XSUB(b.x)], 1u);
        const unsigned gen = old / nloc;
        if (old + 1u == (gen + 1u) * nloc) {
            __builtin_amdgcn_fence(__ATOMIC_RELEASE, "agent");
            asm volatile("s_waitcnt vmcnt(0)" ::: "memory");
            const unsigned og = xb_add(&bar[XB_TOP], 1u);
            const unsigned tg = og / nx;
            if (og + 1u == (tg + 1u) * nx) xb_add(&bar[XB_TOPGEN], 1u);
            else XB_SPIN(xb_ld(&bar[XB_TOPGEN]) == tg, bar);
            __builtin_amdgcn_fence(__ATOMIC_ACQUIRE, "agent");
            xb_add(&bar[XB_XGEN(b.x)], 1u);
            asm volatile("s_waitcnt vmcnt(0)" ::: "memory");
        } else {
            XB_SPIN(xb_ld(&bar[XB_XGEN(b.x)]) == gen, bar);
            __builtin_amdgcn_fence(__ATOMIC_ACQUIRE, "agent");
            asm volatile("s_waitcnt vmcnt(0)" ::: "memory");
        }
    }
    __syncthreads();
}

#define GB_SUB(g) (3584 + 64 * (g))
__device__ __forceinline__ void group_barrier(unsigned* bar, unsigned g, unsigned nloc) {
    asm volatile("s_waitcnt vmcnt(0)" ::: "memory");
    __syncthreads();
    if (TIDX == 0) {
        __builtin_amdgcn_s_waitcnt(0);
        __builtin_amdgcn_fence(__ATOMIC_RELEASE, "agent");
        asm volatile("s_waitcnt vmcnt(0)" ::: "memory");
        unsigned* sub = bar + GB_SUB(g); unsigned* gen = sub + 32;
        const unsigned old = xb_add(sub, 1u), gn = old / nloc;
        if (old + 1u == (gn + 1u) * nloc) xb_add(gen, 1u);
        else XB_SPIN(xb_ld(gen) == gn, bar);
        __builtin_amdgcn_fence(__ATOMIC_ACQUIRE, "agent");
        asm volatile("s_waitcnt vmcnt(0)" ::: "memory");
    }
    __syncthreads();
}

constexpr int BATCH = 8, SEQ = 2048, DM = 2048, MTOK = BATCH * SEQ, DFF = 5632, PLE = 256;
constexpr int A_NQK = 2304, A_NV = 256, B_NQK = 4096, B_NV = 2048;

__device__ __forceinline__ void attnA_phase(LAS unsigned char* lds, const bf16* qk, const bf16* Vt, bf16* ao, const float* gq, const float* gk, const float* sink) {
    constexpr int LDQ = A_NQK, KROW = 144, VROW = 784;
    constexpr int OFF_K = 0, OFF_V = 384 * KROW;
    const int tid = TIDX, lane = tid & 63, wid = __builtin_amdgcn_readfirstlane(tid >> 6), r32 = lane & 31, hi = lane >> 5;
    constexpr float SC2 = 0.125f * LOG2E;
    const float Mb2 = 64.0f * wave_max(fabsf(gq[lane])) * wave_max(fabsf(gk[lane])) * SC2;
    const int vcu = (gridDim.x & 7) == 0 ? (blockIdx.x & 7) * (gridDim.x >> 3) + (blockIdx.x >> 3) : blockIdx.x;
    const bool grp = gridDim.x == 256;
    for (int ui = 0; ui < (grp ? 2 : (BATCH * 4 * 16 + (int)gridDim.x - 1) / (int)gridDim.x); ++ui) {
        const int unit = grp ? (vcu >> 5) * 64 + (vcu & 31) + 32 * ui : vcu + ui * (int)gridDim.x;
        if (unit >= BATCH * 4 * 16) break;
        const int n = unit & 15, kv = (unit >> 4) & 3, b = unit >> 6;
        const int start = n * 128, s0 = start - 128, rowbase = b * SEQ;
        __syncthreads();
#pragma unroll
        for (int i = 0; i < 6; ++i) { const int c = tid + i * 512, row = c >> 3, ch = c & 7, s = s0 + row; u32x4 v = (u32x4){0u, 0u, 0u, 0u};
            if (s >= 0 && s < SEQ) v = *(const u32x4*)(qk + (size_t)(rowbase + s) * LDQ + 2048 + kv * 64 + ch * 8);
            *(LAS u32x4*)(lds + OFF_K + row * KROW + ch * 16) = v; }
#pragma unroll
        for (int i = 0; i < 6; ++i) { const int c = tid + i * 512, d = c / 48, ch = c % 48, s = s0 + ch * 8; u32x4 v = (u32x4){0u, 0u, 0u, 0u};
            if (s >= 0 && s < SEQ) v = *(const u32x4*)(Vt + (size_t)(kv * 64 + d) * MTOK + rowbase + s);
            *(LAS u32x4*)(lds + OFF_V + d * VROW + ch * 16) = v; }
        __syncthreads();
        const int h = kv * 8 + wid;
        const float slope2 = exp2f(-8.0f * (float)(h + 1) / 32.0f) * LOG2E;
        const float sinkterm = exp2f(sink[h] * LOG2E - Mb2);
        for (int j = 0; j < 4; ++j) {
            const int t = start + 32 * j + r32, tok = rowbase + t;
            bf16x8 qf[4];
#pragma unroll
            for (int kk = 0; kk < 4; ++kk) qf[kk] = *(const bf16x8*)(qk + (size_t)tok * LDQ + h * 64 + kk * 16 + hi * 8);
            f32x16 o0 = {}, o1 = {}; float l = 0.f;
            for (int kt = j; kt < j + 9; ++kt) {
                const int sb = s0 + 32 * kt;
                if (sb < 0 || sb >= SEQ) continue;
                const LAS unsigned char* kb = lds + OFF_K + (32 * kt + swap23(r32)) * KROW + hi * 16;
                const LAS unsigned char* vb = lds + OFF_V + r32 * VROW + (32 * kt) * 2 + hi * 16;
                bf16x8 kf[4], vf[4];
#pragma unroll
                for (int kk = 0; kk < 4; ++kk) kf[kk] = *(const LAS bf16x8*)(kb + kk * 32);
                vf[0] = *(const LAS bf16x8*)(vb); vf[1] = *(const LAS bf16x8*)(vb + 32); vf[2] = *(const LAS bf16x8*)(vb + 32 * VROW); vf[3] = *(const LAS bf16x8*)(vb + 32 * VROW + 32);
                const float tf = (float)(t - (sb + 8 * hi));
                f32x16 sacc;
#pragma unroll
                for (int r = 0; r < 16; ++r) sacc[r] = 0.f;
#pragma unroll
                for (int kk = 0; kk < 4; ++kk) sacc = MFMA32(kf[kk], qf[kk], sacc);
                float p[16];
#pragma unroll
                for (int r = 0; r < 16; ++r) { const float dist = fabsf(tf - (float)(16 * (r >> 3) + (r & 7)));
                    const float e = __builtin_amdgcn_exp2f(sacc[r] - slope2 * dist - Mb2); p[r] = (dist <= 128.0f) ? e : 0.f; l += p[r]; }
                u32x4 w0, w1;
                w0.x = pk2(p[0], p[1]); w0.y = pk2(p[2], p[3]); w0.z = pk2(p[4], p[5]); w0.w = pk2(p[6], p[7]);
                w1.x = pk2(p[8], p[9]); w1.y = pk2(p[10], p[11]); w1.z = pk2(p[12], p[13]); w1.w = pk2(p[14], p[15]);
                const bf16x8 pa0 = __builtin_bit_cast(bf16x8, w0), pa1 = __builtin_bit_cast(bf16x8, w1);
                o0 = MFMA32(vf[0], pa0, o0); o1 = MFMA32(vf[2], pa0, o1); o0 = MFMA32(vf[1], pa1, o0); o1 = MFMA32(vf[3], pa1, o1);
            }
            l += __shfl_xor(l, 32); l += sinkterm;
            const float inv = 1.0f / l;
            bf16* op = ao + (size_t)tok * DM + h * 64 + 4 * hi;
#pragma unroll
            for (int gp = 0; gp < 2; ++gp) {
                u32x2 pa[2], pb[2];
#pragma unroll
                for (int e = 0; e < 2; ++e) { const int g4 = 2 * gp + e;
                    pa[e].x = pk2(o0[4 * g4] * inv, o0[4 * g4 + 1] * inv); pa[e].y = pk2(o0[4 * g4 + 2] * inv, o0[4 * g4 + 3] * inv);
                    pb[e].x = pk2(o1[4 * g4] * inv, o1[4 * g4 + 1] * inv); pb[e].y = pk2(o1[4 * g4 + 2] * inv, o1[4 * g4 + 3] * inv); }
                const auto ax = __builtin_amdgcn_permlane32_swap(pa[0].x, pa[1].x, false, false), ay = __builtin_amdgcn_permlane32_swap(pa[0].y, pa[1].y, false, false);
                const auto bx = __builtin_amdgcn_permlane32_swap(pb[0].x, pb[1].x, false, false), by = __builtin_amdgcn_permlane32_swap(pb[0].y, pb[1].y, false, false);
                u32x4 wa, wb; wa.x = ax[0]; wa.y = ay[0]; wa.z = ax[1]; wa.w = ay[1]; wb.x = bx[0]; wb.y = by[0]; wb.z = bx[1]; wb.w = by[1];
                *(u32x4*)(op - 4 * hi + 16 * gp + 8 * hi) = wa; *(u32x4*)(op - 4 * hi + 32 + 16 * gp + 8 * hi) = wb; }
        }
    }
}

constexpr int B_KT = 64 * 256, B_VT = 256 * 128;
constexpr int B_NKS = 3, B_NVS = 2;
constexpr int B_OFF_K = 0, B_OFF_V = B_NKS * B_KT, B_OFF_P = B_OFF_V + B_NVS * B_VT, B_OFF_XCH = B_OFF_P + 2 * 8 * 2048, B_LDS_END = B_OFF_XCH + 1024;
#define GLDS16(g, l) __builtin_amdgcn_global_load_lds((const __attribute__((address_space(1))) unsigned*)(g), (LAS unsigned*)(l), 16, 0, 0)
#define B_WAITV(n) asm volatile("s_waitcnt vmcnt(" #n ")" ::: "memory")
struct BCtx {
    const bf16* ksrc; const bf16* vsrc; int kdelta, vdelta, kro, kx2, vro, vx2, t;
};
__device__ __forceinline__ void b_issue_k(LAS unsigned char* lds, const BCtx& c, int wid, int kt, int slot) {
    GLDS16(c.ksrc + (size_t)(64 * kt) * B_NQK, lds + B_OFF_K + slot * B_KT + wid * 2048);
    GLDS16(c.ksrc + (size_t)(64 * kt + 4) * B_NQK + c.kdelta, lds + B_OFF_K + slot * B_KT + wid * 2048 + 1024);
}
__device__ __forceinline__ void b_issue_v(LAS unsigned char* lds, const BCtx& c, int wid, int kt, int slot) {
#pragma unroll
    for (int i = 0; i < 4; ++i) GLDS16(c.vsrc + (size_t)(8 * i) * MTOK + 64 * kt + ((i & 1) ? c.vdelta : 0), lds + B_OFF_V + slot * B_VT + wid * 4096 + i * 1024);
}
__device__ __forceinline__ void b_scores(LAS unsigned char* lds, const BCtx& c, const bf16x8 (&qf)[8], int kslot, int st, int kt, int t, int hi, float slope2, float Mb2, float (&p)[16], float& l) {
    const LAS unsigned char* kb = lds + B_OFF_K + kslot * B_KT + st * 32 * 256 + c.kro;
    f32x16 sacc = {};
#pragma unroll
    for (int half = 0; half < 2; ++half) {
        bf16x8 kf[4];
#pragma unroll
        for (int kk = 0; kk < 4; ++kk) kf[kk] = *(const LAS bf16x8*)(kb + (((4 * half + kk) * 32) ^ c.kx2));
        __builtin_amdgcn_sched_barrier(0);
#pragma unroll
        for (int kk = 0; kk < 4; ++kk) sacc = MFMA32(kf[kk], qf[4 * half + kk], sacc);
        __builtin_amdgcn_sched_barrier(0);
    }
    const float tf = (float)(t - (64 * kt + 32 * st + 8 * hi));
#pragma unroll
    for (int r = 0; r < 16; ++r) { p[r] = __builtin_amdgcn_exp2f(sacc[r] + (-slope2 * fabsf(tf - (float)(16 * (r >> 3) + (r & 7))) - Mb2)); l += p[r]; }
}
__device__ __forceinline__ float attnB_pass0(LAS unsigned char* lds, const BCtx& c, const bf16x8 (&qf)[8], int t, float slope2, float Mb2, int dh) {
    constexpr int NT = SEQ / 64;
    const int wid = __builtin_amdgcn_readfirstlane(TIDX >> 6), hi = (TIDX & 63) >> 5;
    float l = 0.f;
    __syncthreads();
    b_issue_k(lds, c, wid, 0, 0); b_issue_k(lds, c, wid, 1, 1);
    int ks = 0, ks2 = 2;
    for (int kt = 0; kt < NT; ++kt) {
        if (kt + 1 < NT) B_WAITV(2); else B_WAITV(0);
        __builtin_amdgcn_s_barrier(); asm volatile("" ::: "memory");
        if (kt + 2 < NT) b_issue_k(lds, c, wid, kt + 2, ks2);
        float p[16];
        b_scores(lds, c, qf, ks, dh, kt, t, hi, slope2, Mb2, p, l);
        asm volatile("s_waitcnt lgkmcnt(0)" ::: "memory");
        ks = ks == B_NKS - 1 ? 0 : ks + 1; ks2 = ks2 == B_NKS - 1 ? 0 : ks2 + 1;
    }
    l += __shfl_xor(l, 32);
    return l;
}
#define SGB(mask, n) __builtin_amdgcn_sched_group_barrier((mask), (n), 0)
__device__ __forceinline__ float attnB_passPV(LAS unsigned char* lds, const BCtx& c, const bf16x8 (&qf)[8], f32x16 (&O)[4], float slope2, float Mb2, int dh) {
    const int t = c.t;
    constexpr int NT = SEQ / 64;
    const int lane = TIDX & 63, wid = __builtin_amdgcn_readfirstlane(TIDX >> 6), hi = lane >> 5;
    LAS unsigned char* pmine = lds + B_OFF_P + wid * 2048 + lane * 32;
    const LAS unsigned char* ptheirs = lds + B_OFF_P + (wid ^ 4) * 2048 + lane * 32;
    float l = 0.f;
    u32x4 w0, w1;
    __syncthreads();
    b_issue_k(lds, c, wid, 0, 0); b_issue_k(lds, c, wid, 1, 1); b_issue_v(lds, c, wid, 0, 0);
    B_WAITV(0);
    __builtin_amdgcn_s_barrier(); asm volatile("" ::: "memory");
    b_issue_k(lds, c, wid, 2, 2);
    {
        float p[16];
        b_scores(lds, c, qf, 0, dh, 0, t, hi, slope2, Mb2, p, l);
        w0.x = pk2(p[0], p[1]); w0.y = pk2(p[2], p[3]); w0.z = pk2(p[4], p[5]); w0.w = pk2(p[6], p[7]);
        w1.x = pk2(p[8], p[9]); w1.y = pk2(p[10], p[11]); w1.z = pk2(p[12], p[13]); w1.w = pk2(p[14], p[15]);
        *(LAS u32x4*)(pmine) = w0; *(LAS u32x4*)(pmine + 16) = w1;
    }
    int ks1 = 1, ks3 = 0;
#pragma unroll 1
    for (int kt = 0; kt < NT - 1; ++kt) {
        if (kt + 2 < NT) B_WAITV(2); else B_WAITV(0);
        asm volatile("s_waitcnt lgkmcnt(0)" ::: "memory");
        __builtin_amdgcn_s_barrier(); asm volatile("" ::: "memory");
        b_issue_v(lds, c, wid, kt + 1, (kt + 1) & 1);
        if (kt + 3 < NT) b_issue_k(lds, c, wid, kt + 3, ks3);
        const u32x4 t0 = *(const LAS u32x4*)(ptheirs + (kt & 1) * 16384), t1 = *(const LAS u32x4*)(ptheirs + (kt & 1) * 16384 + 16);
        const bf16x8 pp[4] = {__builtin_bit_cast(bf16x8, dh == 0 ? w0 : t0), __builtin_bit_cast(bf16x8, dh == 0 ? w1 : t1), __builtin_bit_cast(bf16x8, dh == 0 ? t0 : w0), __builtin_bit_cast(bf16x8, dh == 0 ? t1 : w1)};
        const LAS unsigned char* vb = lds + B_OFF_V + (kt & 1) * B_VT + dh * 16384 + c.vro;
        const LAS unsigned char* kb = lds + B_OFF_K + ks1 * B_KT + dh * 32 * 256 + c.kro;
        f32x16 sacc = {};
#pragma unroll
        for (int g = 0; g < 4; ++g) {
            const bf16x8 k0 = *(const LAS bf16x8*)(kb + (((2 * g) * 32) ^ c.kx2)), k1 = *(const LAS bf16x8*)(kb + (((2 * g + 1) * 32) ^ c.kx2));
            bf16x8 vf[4];
#pragma unroll
            for (int dt = 0; dt < 4; ++dt) vf[dt] = *(const LAS bf16x8*)(vb + dt * 4096 + ((32 * g) ^ c.vx2));
            sacc = MFMA32(k0, qf[2 * g], sacc);
            O[0] = MFMA32(vf[0], pp[g], O[0]); O[1] = MFMA32(vf[1], pp[g], O[1]);
            sacc = MFMA32(k1, qf[2 * g + 1], sacc);
            O[2] = MFMA32(vf[2], pp[g], O[2]); O[3] = MFMA32(vf[3], pp[g], O[3]);
        }
        SGB(0x100, 8);
#pragma unroll
        for (int g = 0; g < 4; ++g) { SGB(0x008, 3); SGB(0x100, 3); SGB(0x008, 3); SGB(0x100, 3); }
        __builtin_amdgcn_sched_barrier(0);
        {   const float tf = (float)(t - (64 * (kt + 1) + 32 * dh + 8 * hi));
            float p[16];
#pragma unroll
            for (int r = 0; r < 16; ++r) { p[r] = __builtin_amdgcn_exp2f(sacc[r] + (-slope2 * fabsf(tf - (float)(16 * (r >> 3) + (r & 7))) - Mb2)); l += p[r]; }
            w0.x = pk2(p[0], p[1]); w0.y = pk2(p[2], p[3]); w0.z = pk2(p[4], p[5]); w0.w = pk2(p[6], p[7]);
            w1.x = pk2(p[8], p[9]); w1.y = pk2(p[10], p[11]); w1.z = pk2(p[12], p[13]); w1.w = pk2(p[14], p[15]);
            *(LAS u32x4*)(pmine + ((kt + 1) & 1) * 16384) = w0; *(LAS u32x4*)(pmine + ((kt + 1) & 1) * 16384 + 16) = w1;
        }
        ks1 = ks1 == B_NKS - 1 ? 0 : ks1 + 1; ks3 = ks3 == B_NKS - 1 ? 0 : ks3 + 1;
    }
    {
        constexpr int kt = NT - 1;
        B_WAITV(0);
        asm volatile("s_waitcnt lgkmcnt(0)" ::: "memory");
        __builtin_amdgcn_s_barrier(); asm volatile("" ::: "memory");
        const u32x4 t0 = *(const LAS u32x4*)(ptheirs + (kt & 1) * 16384), t1 = *(const LAS u32x4*)(ptheirs + (kt & 1) * 16384 + 16);
        const bf16x8 pp[4] = {__builtin_bit_cast(bf16x8, dh == 0 ? w0 : t0), __builtin_bit_cast(bf16x8, dh == 0 ? w1 : t1), __builtin_bit_cast(bf16x8, dh == 0 ? t0 : w0), __builtin_bit_cast(bf16x8, dh == 0 ? t1 : w1)};
        const LAS unsigned char* vb = lds + B_OFF_V + (kt & 1) * B_VT + dh * 16384 + c.vro;
#pragma unroll
        for (int g = 0; g < 4; ++g) {
            bf16x8 vf[4];
#pragma unroll
            for (int dt = 0; dt < 4; ++dt) vf[dt] = *(const LAS bf16x8*)(vb + dt * 4096 + ((32 * g) ^ c.vx2));
#pragma unroll
            for (int dt = 0; dt < 4; ++dt) O[dt] = MFMA32(vf[dt], pp[g], O[dt]);
        }
    }
    l += __shfl_xor(l, 32);
    return l;
}
__device__ __forceinline__ BCtx b_make_ctx(const bf16* kbase  , const bf16* vbase  , int tbase) {
    int lane = TIDX & 63; asm volatile("" : "+v"(lane));
    const int wid = __builtin_amdgcn_readfirstlane(TIDX >> 6), r32 = lane & 31, hi = lane >> 5;
    BCtx c;
    const int kr = wid * 8 + (lane >> 4), kc = (lane & 15) ^ (kr & 15), vr = wid * 32 + (lane >> 3), vc = (lane & 7) ^ ((vr >> 1) & 7);
    c.kdelta = (kc & 4) ? -32 : 32; c.vdelta = (vc & 4) ? -32 : 32;
    const int krow = swap23(r32), kx = (krow & 15) * 16; c.kro = krow * 256 + ((hi * 16) ^ (kx & 16)); c.kx2 = kx & ~16;
    const int vx = ((r32 >> 1) & 7) * 16; c.vro = r32 * 128 + ((hi * 16) ^ (vx & 16)); c.vx2 = vx & ~16;
    c.ksrc = kbase + (size_t)kr * B_NQK + kc * 8; c.vsrc = vbase + (size_t)vr * MTOK + vc * 8; c.t = tbase + r32;
    return c;
}
__device__ __forceinline__ void attnB_phase(LAS unsigned char* lds, const bf16* qk, const bf16* Vt, bf16* ao, float* park  ,
                                            const float* gq, const float* gk, const float* lamv, const float* subln, const float lambda_init) {
    constexpr int LDQ = B_NQK;
    const int tid = TIDX, lane = tid & 63, wid = __builtin_amdgcn_readfirstlane(tid >> 6), r32 = lane & 31, hi = lane >> 5;
    const int qg = wid & 3, dh = wid >> 2;
    LAS float* xch = (LAS float*)(lds + B_OFF_XCH);
    const float SC2 = 0.08838834764831845f * LOG2E;
    const float mq = wave_max(fmaxf(fabsf(gq[lane]), fabsf(gq[lane + 64]))), mk = wave_max(fmaxf(fabsf(gk[lane]), fabsf(gk[lane + 64])));
    const float Mb2 = 128.0f * mq * mk * SC2;
    const float s01 = wave_sum(lamv[lane] * lamv[128 + lane] + lamv[64 + lane] * lamv[192 + lane]);
    const float s23 = wave_sum(lamv[256 + lane] * lamv[384 + lane] + lamv[320 + lane] * lamv[448 + lane]);
    const float lam = expf(s01) - expf(s23) + lambda_init;
    const int vcu = (gridDim.x & 7) == 0 ? (blockIdx.x & 7) * (gridDim.x >> 3) + (blockIdx.x >> 3) : blockIdx.x;
    const bool grp = gridDim.x == 256;
    for (int ui = 0; ui < (grp ? 4 : (BATCH * 8 * 16 + (int)gridDim.x - 1) / (int)gridDim.x); ++ui) {
        const int unit = grp ? (vcu >> 5) * 128 + (vcu & 31) + 32 * ui : vcu + ui * (int)gridDim.x;
        if (unit >= BATCH * 8 * 16) break;
        const int qb = unit & 15, h = (unit >> 4) & 7, b = unit >> 7;
        const int rowbase = b * SEQ, tbase = qb * 128 + qg * 32;
        const float slope2 = exp2f(-(float)(h + 1)) * LOG2E;
        const bf16* k0 = qk + (size_t)rowbase * LDQ + 2048 + h * 256;
        const bf16* vb0 = Vt + (size_t)(h * 256) * MTOK + rowbase;
        const bf16* qrow = qk + (size_t)(rowbase + tbase) * LDQ + h * 256;
        f32x16 O[4];
        bf16x8 qf[8];
#define B_LANE(ln_) int ln_ = TIDX & 63; asm volatile("" : "+v"(ln_))
#define B_LOAD_Q(sub) do { B_LANE(ln_); const bf16* qp_ = qrow + (size_t)(ln_ & 31) * LDQ + (sub) * 128 + (ln_ >> 5) * 8; \
            _Pragma("unroll") for (int kk = 0; kk < 8; ++kk) qf[kk] = *(const bf16x8*)(qp_ + kk * 16); } while (0)
#pragma unroll
        for (int dt = 0; dt < 4; ++dt) O[dt] = (f32x16){};
        B_LOAD_Q(0);
        float l1 = attnB_passPV(lds, b_make_ctx(k0, vb0, tbase), qf, O, slope2, Mb2, dh);
        __syncthreads();
        { B_LANE(ln_); if (ln_ < 32) xch[wid * 32 + ln_] = l1; }
        __syncthreads();
        { B_LANE(ln_); l1 += xch[(wid ^ 4) * 32 + (ln_ & 31)]; }
        { B_LANE(ln_); f32x4* pk = (f32x4*)(park + ((size_t)blockIdx.x * 8 + wid) * 4096) + ln_; const float inv1 = 1.0f / l1;
#pragma unroll
          for (int dt = 0; dt < 4; ++dt)
#pragma unroll
              for (int q4 = 0; q4 < 4; ++q4) pk[(dt * 4 + q4) * 64] = (f32x4){O[dt][4 * q4] * inv1, O[dt][4 * q4 + 1] * inv1, O[dt][4 * q4 + 2] * inv1, O[dt][4 * q4 + 3] * inv1}; }
#pragma unroll
        for (int dt = 0; dt < 4; ++dt) O[dt] = (f32x16){};
        B_LOAD_Q(1);
        float l2 = attnB_passPV(lds, b_make_ctx(k0 + 128, vb0, tbase), qf, O, slope2, Mb2, dh);
        __syncthreads();
        { B_LANE(ln_); if (ln_ < 32) xch[wid * 32 + ln_] = l2; }
        __syncthreads();
        { B_LANE(ln_); l2 += xch[(wid ^ 4) * 32 + (ln_ & 31)]; }
        { B_LANE(ln_); const f32x4* pk = (const f32x4*)(park + ((size_t)blockIdx.x * 8 + wid) * 4096) + ln_; const float c2 = lam / l2;
          asm volatile("s_waitcnt vmcnt(0)" ::: "memory"); __builtin_amdgcn_fence(__ATOMIC_ACQUIRE, "agent");
#pragma unroll
          for (int dt = 0; dt < 4; ++dt)
#pragma unroll
              for (int q4 = 0; q4 < 4; ++q4) { const f32x4 p1 = pk[(dt * 4 + q4) * 64];
#pragma unroll
                  for (int e = 0; e < 4; ++e) O[dt][4 * q4 + e] = p1[e] - c2 * O[dt][4 * q4 + e]; } }
#undef B_LOAD_Q
        float ss = 0.f;
#pragma unroll
        for (int dt = 0; dt < 4; ++dt)
#pragma unroll
            for (int r = 0; r < 16; ++r) ss += O[dt][r] * O[dt][r];
        ss += __shfl_xor(ss, 32);
        B_LANE(ln);
        __syncthreads();
        if (ln < 32) xch[wid * 32 + ln] = ss;
        __syncthreads();
        ss += xch[(wid ^ 4) * 32 + (ln & 31)];
        const float rs = __builtin_amdgcn_rsqf(ss * (1.0f / 256.0f) + EPS) * (1.0f - lambda_init);
        const int hi2 = ln >> 5;
        bf16* op = ao + (size_t)(rowbase + tbase + (ln & 31)) * DM + h * 256 + dh * 128;
#pragma unroll
        for (int dt = 0; dt < 4; ++dt)
#pragma unroll
            for (int gp = 0; gp < 2; ++gp) { u32x2 pc[2];
#pragma unroll
                for (int e = 0; e < 2; ++e) { const int g4 = 2 * gp + e; const f32x4 sg = *(const f32x4*)(subln + dh * 128 + dt * 32 + 8 * g4 + 4 * hi2);
                    pc[e].x = pk2(O[dt][4 * g4] * rs * sg[0], O[dt][4 * g4 + 1] * rs * sg[1]); pc[e].y = pk2(O[dt][4 * g4 + 2] * rs * sg[2], O[dt][4 * g4 + 3] * rs * sg[3]); }
                const auto sx = __builtin_amdgcn_permlane32_swap(pc[0].x, pc[1].x, false, false), sy = __builtin_amdgcn_permlane32_swap(pc[0].y, pc[1].y, false, false);
                u32x4 w; w.x = sx[0]; w.y = sy[0]; w.z = sx[1]; w.w = sy[1];
                *(u32x4*)(op + dt * 32 + 16 * gp + 8 * hi2) = w; }
#undef B_LANE
    }
}

constexpr size_t MiB = 1u << 20;
constexpr size_t SZ_WQKVA = (size_t)2560 * 2048 * 2, SZ_WSQ = (size_t)2048 * 2048 * 2, SZ_WQKVB = (size_t)6144 * 2048 * 2, SZ_WIN = (size_t)11264 * 2048 * 2, SZ_WOUT = (size_t)2048 * 5632 * 2, SZ_WP = (size_t)2048 * 256 * 2;
constexpr size_t WS_WQKVA = 0, WS_WOA = WS_WQKVA + SZ_WQKVA, WS_WQKVB = WS_WOA + SZ_WSQ, WS_WOB = WS_WQKVB + SZ_WQKVB, WS_WIN0 = WS_WOB + SZ_WSQ, WS_WIN1 = WS_WIN0 + SZ_WIN,
                 WS_WOUT0 = WS_WIN1 + SZ_WIN, WS_WOUT1 = WS_WOUT0 + SZ_WOUT, WS_WG0 = WS_WOUT1 + SZ_WOUT, WS_WG1 = WS_WG0 + SZ_WSQ, WS_WP0 = WS_WG1 + SZ_WSQ, WS_WP1 = WS_WP0 + SZ_WP, WS_WEND = WS_WP1 + SZ_WP;
static_assert(WS_WEND == 200 * MiB, "weights");
constexpr size_t WS_HBA = 200 * MiB, WS_HBB = 264 * MiB, WS_PB0 = 328 * MiB, WS_PB1 = 336 * MiB, WS_QK = 344 * MiB, WS_VT = 472 * MiB, WS_ACT = 344 * MiB  ,
                 WS_AO = 536 * MiB, WS_PP = 600 * MiB, WS_PART = 664 * MiB, WS_SSQ = 672 * MiB, WS_BAR = 673 * MiB, WS_END = 674 * MiB;
constexpr int LDS_MISC_OFF = 156 * 1024 - 64;
static_assert(WS_ACT + (size_t)MTOK * DFF * 2 <= WS_AO, "act overlay");
enum { SQ_X = 0, SQ_1, SQ_2, SQ_3, SQ_4, SQ_5, SQ_PP0, SQ_PP1, SQ_N };

constexpr int LDS_BYTES = 156 * 1024;
static_assert(B_LDS_END <= LDS_BYTES, "attention B LDS");

struct Args {
    const float* in[21]; float* out; unsigned char* ws; int ph_lo, ph_hi;
};

constexpr int TR_WAVE_BYTES = 17408;
template <bool INTERLEAVE>
__device__ __forceinline__ void transpose_item(const float* W, int K, int N, bf16* WT, const float* gain, LAS unsigned* scr, int item, int lane) {
    const int nblk = N / 128, kb = item / nblk, nb = item % nblk, k0 = 64 * kb, n0 = 128 * nb;
    int r0 = n0;
    if (INTERLEAVE) { const int up = n0 >= DFF ? 1 : 0, j = n0 - up * DFF; r0 = (j >> 7) * 256 + up * 128 + (j & 127); }
    const int half = lane >> 5, nl = (lane & 31) * 4;
    const float* src = W + (size_t)(k0 + 2 * half) * N + n0 + nl;
#pragma unroll 4
    for (int i = 0; i < 16; ++i) {
        f32x4 a = *(const f32x4*)(src + (size_t)(4 * i) * N), b = *(const f32x4*)(src + (size_t)(4 * i + 1) * N);
        if (gain) { const float g0 = gain[k0 + 4 * i + 2 * half], g1 = gain[k0 + 4 * i + 2 * half + 1]; a = a * g0; b = b * g1; }
        const int cw = 2 * i + half;
#pragma unroll
        for (int e = 0; e < 4; ++e) { const int r = nl + e; scr[r * 33 + (r >> 5) + cw] = pk2(a[e], b[e]); }
    }
    asm volatile("s_waitcnt lgkmcnt(0)" ::: "memory");
    const int ch = lane & 7;
#pragma unroll 4
    for (int j = 0; j < 16; ++j) { const int r = j * 8 + (lane >> 3); const LAS unsigned* sp = scr + r * 33 + (r >> 5) + ch * 4;
        u32x4 o; o.x = sp[0]; o.y = sp[1]; o.z = sp[2]; o.w = sp[3];
        *(u32x4*)(WT + (size_t)(r0 + r) * K + k0 + 8 * ch) = o; }
    asm volatile("s_waitcnt lgkmcnt(0)" ::: "memory");
}
template <bool INTERLEAVE>
__device__ __forceinline__ void transpose_job(const float* W, int K, int N, bf16* WT, const float* gain, LAS unsigned* scr, int gw, int NGW, int lane) {
    const int nitems = (K / 64) * (N / 128);
    for (int it = gw; it < nitems; it += NGW) transpose_item<INTERLEAVE>(W, K, N, WT, gain, scr, it, lane);
}

#ifndef REP_PRO
#define REP_PRO 1
#endif
#ifndef REP_ATTNA
#define REP_ATTNA 1
#endif
#ifndef REP_ATTNB
#define REP_ATTNB 1
#endif
#ifndef EXTRA_SYNCS
#define EXTRA_SYNCS 0
#endif
typedef const __attribute__((address_space(4))) Args* KArgs;
struct Ptrs {
    KArgs a;
    __device__ __forceinline__ explicit Ptrs(KArgs a_) : a(a_) {}
    __device__ __forceinline__ bf16* w(size_t off) const { return (bf16*)(a->ws + off); }
    __device__ __forceinline__ pg8::sq_t* ssq(int k) const { return (pg8::sq_t*)(a->ws + WS_SSQ) + (size_t)k * MTOK; }
};
#ifdef ONLY
constexpr int ONLYK = ONLY;
#else
constexpr int ONLYK = -1;
#endif
#define IN(k) (lo <= (k) && (k) < hi)
#define SEAM(k) do { if (IN(k) && IN((k) + 1)) { if (hi > 1000000) grid.sync(); else if ((k) == 0 || gridDim.x != 256) xcd_barrier(xbar); else group_barrier(xbar.bar, blockIdx.x & 7u, gridDim.x >> 3); } } while (0)
typedef pg8::StaticOrder SO;

template <int L>
__device__ __forceinline__ void layer_body(KArgs a, LAS unsigned char* lds, cg::grid_group& grid, const XcdBarrier& xbar, const int lo, const int hi) {
    const Ptrs P_(a);
    const int G = gridDim.x, cu = blockIdx.x;
    constexpr int P = 1 + 6 * L;
    constexpr size_t WS_HB_IN = L == 0 ? WS_HBA : WS_HBB, WS_HB_MID = L == 0 ? WS_HBB : WS_HBA;
    constexpr int K_IN = L == 0 ? SQ_X : SQ_3, K_MIX = L == 0 ? SQ_1 : SQ_4, K_FFN = L == 0 ? SQ_2 : SQ_5, K_PP = L == 0 ? SQ_PP0 : SQ_PP1;
    constexpr size_t WS_WQKV = L == 0 ? WS_WQKVA : WS_WQKVB, WS_WO = L == 0 ? WS_WOA : WS_WOB, WS_WIN = L == 0 ? WS_WIN0 : WS_WIN1, WS_WOUT = L == 0 ? WS_WOUT0 : WS_WOUT1,
                     WS_WG = L == 0 ? WS_WG0 : WS_WG1, WS_WP = L == 0 ? WS_WP0 : WS_WP1, WS_PB = L == 0 ? WS_PB0 : WS_PB1;
    constexpr int nqk = L == 0 ? A_NQK : B_NQK, nv = L == 0 ? A_NV : B_NV;
    if (IN(P)) {
        if (ONLYK < 0 || ONLYK == 1) { pg8::Gemm g{P_.w(WS_HB_IN), P_.w(WS_WQKV), MTOK, nqk, 2048}; SO S; S.init(MTOK, nqk, G, cu); pg8::EpiQK E{P_.w(WS_QK), nqk, P_.ssq(K_IN), L == 0 ? a->in[5] : a->in[10], L == 0 ? a->in[6] : a->in[11], L == 0 ? 64 : 128, (L == 0 ? 0.125f : 0.08838834764831845f) * LOG2E, (LAS float*)(lds + 131072)};
          pg8::gemm_phase<pg8::EpiQK, SO, true, true>(lds, g, S, E); }
        if (ONLYK < 0 || ONLYK == 2) { pg8::Gemm g{P_.w(WS_WQKV) + (size_t)nqk * 2048, P_.w(WS_HB_IN), nv, MTOK, 2048}; SO S; S.init(nv, MTOK, G, (L == 0 && G == 256) ? ((cu + 64) & 255) : cu); pg8::EpiVt E{P_.w(WS_VT), MTOK, P_.ssq(K_IN)};
          pg8::gemm_phase<pg8::EpiVt, SO, true, true>(lds, g, S, E); }
        if (ONLYK < 0 || ONLYK == 3) { pg8::Gemm g{P_.w(WS_PB), P_.w(WS_WP), MTOK, 2048, 256}; SO S; if (L == 0 && G == 256) S.init(MTOK, 2048, 128, (cu >= 64 && cu < 192) ? cu - 64 : (1 << 20)); else S.init(MTOK, 2048, G, cu); pg8::EpiPP E{P_.w(WS_PP), P_.ssq(K_PP)};
          pg8::gemm_phase<pg8::EpiPP, SO, true, true>(lds, g, S, E); }
    }
    SEAM(P);
    if (IN(P + 1)) {
#ifdef DEBUG_COPYQ
        if (L == 0) { const bf16* q_ = P_.w(WS_QK); bf16* ao_ = P_.w(WS_AO);
            for (size_t i = (size_t)blockIdx.x * 512 + TIDX; i < (size_t)MTOK * DM; i += (size_t)gridDim.x * 512) { const size_t r_ = i / DM, c_ = i % DM;
                const float v_ = __uint_as_float((unsigned)q_[r_ * A_NQK + c_] << 16) + __uint_as_float((unsigned)q_[r_ * A_NQK + 2048 + (c_ & 255)] << 16);
                ao_[i] = (bf16)(__float_as_uint(v_) >> 16); } }
#endif
#ifndef SKIP_A
        if (L == 0) for (int rep = 0; rep < REP_ATTNA; ++rep) attnA_phase(lds, P_.w(WS_QK), P_.w(WS_VT), P_.w(WS_AO), a->in[5], a->in[6], a->in[7]);
#endif
#ifndef SKIP_B
        if (L == 1) for (int rep = 0; rep < REP_ATTNB; ++rep) attnB_phase(lds, P_.w(WS_QK), P_.w(WS_VT), P_.w(WS_AO), (float*)P_.w(WS_HB_MID), a->in[10], a->in[11], a->in[12], a->in[13], (float)(0.8 - 0.6 * 0.7408182206817179));
#endif
    }
    SEAM(P + 1);
    if (IN(P + 2)) {
        if (ONLYK < 0 || ONLYK == 4) { pg8::Gemm g{P_.w(WS_AO), P_.w(WS_WO), MTOK, 2048, 2048}; SO S; S.init(MTOK, 2048, G, cu);
          pg8::EpiRes E{P_.w(WS_HB_IN), P_.w(WS_HB_MID), P_.ssq(K_MIX)};
          pg8::gemm_phase<pg8::EpiRes, SO, true, true>(lds, g, S, E); }
    }
    SEAM(P + 2);
    if (IN(P + 3)) {
        if (ONLYK < 0 || ONLYK == 5) { pg8::Gemm g{P_.w(WS_HB_MID), P_.w(WS_WIN), MTOK, 2 * DFF, 2048}; SO S; S.init(MTOK, 2 * DFF, G, cu);
          pg8::EpiSwiGLU E{P_.w(WS_ACT), P_.ssq(K_MIX)};
          pg8::gemm_phase<pg8::EpiSwiGLU, SO, true, true>(lds, g, S, E); }
    }
    SEAM(P + 3);
    if (IN(P + 4)) {
        if (ONLYK < 0 || ONLYK == 4) { pg8::Gemm g{P_.w(WS_ACT), P_.w(WS_WOUT), MTOK, 2048, DFF}; SO S; S.init(MTOK, 2048, G, cu);
          pg8::EpiRes E{P_.w(WS_HB_MID), P_.w(WS_HB_IN), P_.ssq(K_FFN)};
          pg8::gemm_phase<pg8::EpiRes, SO, true, true>(lds, g, S, E); }
    }
    SEAM(P + 4);
    if (IN(P + 5)) {
        if (ONLYK < 0 || ONLYK == 6) { pg8::Gemm g{P_.w(WS_HB_IN), P_.w(WS_WG), MTOK, 2048, 2048}; SO S; S.init(MTOK, 2048, G, cu);
          pg8::EpiPLE E{P_.w(WS_HB_IN), L == 0 ? nullptr : a->out, L == 0 ? P_.w(WS_HB_MID) : nullptr, P_.ssq(SQ_3), P_.ssq(K_FFN), P_.ssq(K_PP), P_.w(WS_PP), a->in[18] + L * 2048};
          pg8::gemm_phase<pg8::EpiPLE, SO, true, true>(lds, g, S, E); }
    }
    if (L == 0) SEAM(P + 5);
}

__device__ __forceinline__ void prologue_phase(KArgs a, LAS unsigned char* lds) {
    const int tid = TIDX, lane = tid & 63, wave = __builtin_amdgcn_readfirstlane(tid >> 6);
    const int G = gridDim.x, cu = blockIdx.x;
    const Ptrs P_(a);
    LAS unsigned* scr = (LAS unsigned*)(lds + wave * TR_WAVE_BYTES);
    const int gw = cu * 8 + wave, NGW = G * 8;
    const float* attn_norm = a->in[2]; const float* ffn_norm = a->in[3];
    {   constexpr int I_QA = 32 * 20, I_SQ = 32 * 16, I_QB = 32 * 48, I_IN = 32 * 88, I_OUT = 88 * 16, I_P = 4 * 16;
        constexpr int E0 = I_QA, E1 = E0 + I_SQ, E2 = E1 + I_QB, E3 = E2 + I_SQ, E4 = E3 + 2 * I_IN, E5 = E4 + 2 * I_OUT, E6 = E5 + 2 * I_SQ, E7 = E6 + 2 * I_P;
        for (int it = gw; it < E7; it += NGW) {
            if (it < E0) transpose_item<false>(a->in[4], 2048, 2560, P_.w(WS_WQKVA), attn_norm, scr, it, lane);
            else if (it < E1) transpose_item<false>(a->in[8], 2048, 2048, P_.w(WS_WOA), nullptr, scr, it - E0, lane);
            else if (it < E2) transpose_item<false>(a->in[9], 2048, 6144, P_.w(WS_WQKVB), attn_norm + 2048, scr, it - E1, lane);
            else if (it < E3) transpose_item<false>(a->in[14], 2048, 2048, P_.w(WS_WOB), nullptr, scr, it - E2, lane);
            else if (it < E4) { const int i = (it - E3) / I_IN; transpose_item<true>(a->in[15] + (size_t)i * 2048 * 11264, 2048, 11264, P_.w(WS_WIN0 + i * SZ_WIN), ffn_norm + i * 2048, scr, (it - E3) % I_IN, lane); }
            else if (it < E5) { const int i = (it - E4) / I_OUT; transpose_item<false>(a->in[16] + (size_t)i * 5632 * 2048, 5632, 2048, P_.w(WS_WOUT0 + i * SZ_WOUT), nullptr, scr, (it - E4) % I_OUT, lane); }
            else if (it < E6) { const int i = (it - E5) / I_SQ; transpose_item<false>(a->in[20] + (size_t)i * 2048 * 2048, 2048, 2048, P_.w(WS_WG0 + i * SZ_WSQ), a->in[19] + i * 2048, scr, (it - E5) % I_SQ, lane); }
            else { const int i = (it - E6) / I_P; transpose_item<false>(a->in[17] + (size_t)i * 256 * 2048, 256, 2048, P_.w(WS_WP0 + i * SZ_WP), nullptr, scr, (it - E6) % I_P, lane); }
        }
    }
    const float* x = a->in[0]; bf16* hbA = P_.w(WS_HBA); pg8::sq_t* SSQ = P_.ssq(0);
    for (int m = gw; m < MTOK; m += NGW) {
        const f32x4* xr = (const f32x4*)(x + (size_t)m * DM) + lane; u32x2* o = (u32x2*)(hbA + (size_t)m * DM) + lane; float s = 0.f;
#pragma unroll
        for (int j = 0; j < 8; ++j) { const f32x4 v = xr[64 * j]; s += pg8::sq4(v); u32x2 w; w.x = pk2(v[0], v[1]); w.y = pk2(v[2], v[3]); o[64 * j] = w; }
        s = wave_sum(s); if (lane == 0) SSQ[SQ_X * MTOK + m] = pg8::f2sq(s);
    }
    { const size_t n8 = (size_t)2 * MTOK * PLE / 8; bf16* pbb = P_.w(WS_PB0); const float* pin = a->in[1];
      for (size_t i = (size_t)cu * 512 + tid; i < n8; i += (size_t)G * 512) { const f32x4 v0 = *(const f32x4*)(pin + i * 8), v1 = *(const f32x4*)(pin + i * 8 + 4); *(u32x4*)(pbb + i * 8) = pg8::pack8(v0, v1); } }
    for (int i = cu * 512 + tid; i < (SQ_N - 1) * MTOK; i += G * 512) SSQ[MTOK + i] = 0ull;
}

__global__ void __launch_bounds__(512, 2) fwd_kernel(Args a_unused) {
    KArgs a = (KArgs)__builtin_amdgcn_kernarg_segment_ptr();
    extern __shared__ __attribute__((aligned(16))) unsigned char lds_raw[];
    LAS unsigned char* lds = (LAS unsigned char*)lds_raw;
    cg::grid_group grid = cg::this_grid();
    if ((threadIdx.x & 63) == 0) ((volatile LAS int*)(LDS_WTAB_OFF))[hw_wave_key()] = (int)(threadIdx.x >> 6);
    __syncthreads();
    const int lo = a->ph_lo, hi = a->ph_hi;
    volatile LAS unsigned* misc = (volatile LAS unsigned*)(lds + LDS_MISC_OFF);
    if (TIDX < 16) misc[TIDX] = 0u;
    __syncthreads();
    XcdBarrier xbar; xbar.bar = (unsigned*)(a->ws + WS_BAR); xbar.x = 0; xbar.st = misc;
    if (hi - lo > 1) xbar = xcd_barrier_post((unsigned*)(a->ws + WS_BAR), misc);
    if (IN(0)) { for (int rep = 0; rep < REP_PRO; ++rep) { prologue_phase(a, lds); __syncthreads(); } }
    for (int rep = 0; rep < EXTRA_SYNCS; ++rep) grid.sync();
    SEAM(0);
    layer_body<0>(a, lds, grid, xbar, lo, hi);
    layer_body<1>(a, lds, grid, xbar, lo, hi);
}
#undef IN
#undef SEAM

constexpr int N_PHASES = 13;
#ifndef N_LAUNCH_SPLIT
#define N_LAUNCH_SPLIT 0
#endif

extern "C" void kernel_launch(void* const* d_in, const int* in_sizes, int n_in, void* d_out, int out_size, void* d_ws, size_t ws_size, hipStream_t stream) {
    static int grid = 0;
    if (grid == 0) {
        if (n_in != 21 || out_size != MTOK * DM || ws_size < WS_END) { fprintf(stderr, "kernel_launch: unexpected shapes (n_in %d, out %d, ws %zu)\n", n_in, out_size, ws_size); grid = -1; return; }
        int dev = 0, cus = 0, per_cu = 0;
        hipGetDevice(&dev); hipDeviceGetAttribute(&cus, hipDeviceAttributeMultiprocessorCount, dev);
        if (hipFuncSetAttribute((const void*)fwd_kernel, hipFuncAttributeMaxDynamicSharedMemorySize, LDS_BYTES) != hipSuccess) { fprintf(stderr, "kernel_launch: hipFuncSetAttribute failed\n"); grid = -1; return; }
        if (hipOccupancyMaxActiveBlocksPerMultiprocessor(&per_cu, (const void*)fwd_kernel, 512, LDS_BYTES) != hipSuccess || per_cu < 1) { fprintf(stderr, "kernel_launch: occupancy query says %d\n", per_cu); per_cu = 1; }
        (void)hipGetLastError();
        grid = cus * per_cu;
        fprintf(stderr, "kernel_launch: grid %d (cus %d x %d)\n", grid, cus, per_cu);
    }
    if (grid < 0) return;
    Args a{};
    for (int i = 0; i < 21; ++i) a.in[i] = (const float*)d_in[i];
    a.out = (float*)d_out; a.ws = (unsigned char*)d_ws;
    if (hipMemsetAsync((char*)d_ws + WS_BAR, 0, 16384, stream) != hipSuccess) { fprintf(stderr, "kernel_launch: memset of the barrier words failed\n"); return; }
#if N_LAUNCH_SPLIT
    for (int ph = 0; ph < N_PHASES; ++ph) { a.ph_lo = ph; a.ph_hi = ph + 1; hipLaunchKernelGGL(fwd_kernel, dim3(grid), dim3(512), LDS_BYTES, stream, a); }
#else
    a.ph_lo = 0; a.ph_hi = N_PHASES;
    void* args[] = {&a};
    hipError_t e = hipLaunchCooperativeKernel((const void*)fwd_kernel, dim3(grid), dim3(512), args, LDS_BYTES, stream);
    if (e != hipSuccess) fprintf(stderr, "kernel_launch: cooperative launch failed: %s (grid %d)\n", hipGetErrorString(e), grid);
#endif
}
```

```cpp
#include <hip/hip_runtime.h>
#include <hip/hip_cooperative_groups.h>
#include <cstdio>
#include <cstdint>
namespace cg = cooperative_groups;
constexpr int LDS_WTAB_OFF = 156 * 1024 - 64 - 256;
__device__ __forceinline__ unsigned hw_wave_key() { return __builtin_amdgcn_s_getreg((5 << 11) | 4) & 63u; }
__device__ __forceinline__ int tid_now() {
    const int w = ((volatile __attribute__((address_space(3))) int*)(LDS_WTAB_OFF))[hw_wave_key()];
    int lane; asm volatile("v_mbcnt_lo_u32_b32 %0, -1, 0\n\tv_mbcnt_hi_u32_b32 %0, -1, %0" : "=v"(lane));
    return __builtin_amdgcn_readfirstlane(w) * 64 + lane;
}
#define TIDX tid_now()
namespace pg8 {
#define PG8_LAS __attribute__((address_space(3)))
typedef unsigned short bf16_t;
typedef short bf16x8 __attribute__((ext_vector_type(8)));
typedef float f32x4 __attribute__((ext_vector_type(4)));
typedef unsigned u32x4 __attribute__((ext_vector_type(4)));
constexpr int BM = 256, BK = 64, HALF = 128, HTB = HALF * BK * 2  , STAGE_BYTES = 8 * HTB, NXCD = 8, WGM = 8;

__host__ __device__ __forceinline__ int lds_byte(int r, int c) { const int st = (r >> 4) * 2 + (c >> 5), rr = r & 15, cc = c & 31, ob = rr * 64 + cc * 2; return st * 1024 + (ob ^ (((ob >> 9) & 1) << 5)); }
__host__ __device__ __forceinline__ void stage_rc(int b, int& R, int& C) { const int st = b / 1024, sb = b % 1024, swz = sb ^ (((sb >> 9) & 1) << 5); R = (st >> 1) * 16 + swz / 64; C = (st & 1) * 32 + (swz % 64) / 2; }
__host__ __device__ __forceinline__ int perm32(int rho) { const int n = rho >> 4, i = rho & 15; return 8 * (i >> 2) + 4 * n + (i & 3); }

struct Unit { int pm, pn; };
struct Gemm { const bf16_t* A; const bf16_t* Bt; int M, N, K; };

struct StaticOrder {
    int nM, nN, nwg, G, c;
    __host__ __device__ void init(int M, int N, int G_, int c_) { nM = M / BM; nN = N / BM; nwg = nM * nN; G = G_; c = c_; }
    __host__ __device__ bool next(int i, Unit& u) const {
        const long L = (long)i * G + c; if (L >= nwg) return false;
        int wgid = (int)L; { const int q = nwg / NXCD, r = nwg % NXCD, xcd = wgid % NXCD, off = wgid / NXCD; wgid = (xcd < r ? xcd * (q + 1) : r * (q + 1) + (xcd - r) * q) + off; }
        const int nig = WGM * nN, gid = wgid / nig, fm = gid * WGM, gsz = (nM - fm) < WGM ? (nM - fm) : WGM;
        u.pm = fm + ((wgid % nig) % gsz); u.pn = (wgid % nig) / gsz; return true;
    }
    __device__ __forceinline__ void a_ready(const Unit&) const {}
    __device__ __forceinline__ void done(const Unit&) const {}
};

__device__ __forceinline__ unsigned cvt_pk_bf16(float lo, float hi) { unsigned r; asm volatile("v_cvt_pk_bf16_f32 %0, %1, %2" : "=v"(r) : "v"(lo), "v"(hi)); return r; }
typedef float f32x2 __attribute__((ext_vector_type(2)));
typedef unsigned u32x2 __attribute__((ext_vector_type(2)));
constexpr float RMS_EPS = 1e-6f;
typedef unsigned long long sq_t;
__device__ __forceinline__ float sq2f(sq_t v) { return (float)v * (1.0f / 1048576.0f); }
__device__ __forceinline__ sq_t f2sq(float s) { return (sq_t)(s * 1048576.0f + 0.5f); }
constexpr float LOG2E_F = 1.4426950408889634f;
__device__ __forceinline__ float rs_from_ssq(float ssq, float inv_n) { return __builtin_amdgcn_rsqf(ssq * inv_n + RMS_EPS); }
__device__ __forceinline__ float sq4(const f32x4 v) { return (v[0] * v[0] + v[1] * v[1]) + (v[2] * v[2] + v[3] * v[3]); }
__device__ __forceinline__ u32x4 pack8(const f32x4 a, const f32x4 b) { u32x4 w; w.x = cvt_pk_bf16(a[0], a[1]); w.y = cvt_pk_bf16(a[2], a[3]); w.z = cvt_pk_bf16(b[0], b[1]); w.w = cvt_pk_bf16(b[2], b[3]); return w; }
__device__ __forceinline__ float bflo(unsigned w) { return __uint_as_float(w << 16); }
__device__ __forceinline__ float bfhi(unsigned w) { return __uint_as_float(w & 0xffff0000u); }
__device__ __forceinline__ float sigmoid_f(float x) { return __builtin_amdgcn_rcpf(1.0f + __builtin_amdgcn_exp2f(-x * LOG2E_F)); }

struct EpiQK {
    static constexpr bool PERM = true, AFTER_DRAIN = false;
    bf16_t* O; int ldc; const sq_t* ssq_in; const float* gq; const float* gk; int hd; float qscale; PG8_LAS float* xq;
    __device__ __forceinline__ void operator()(const f32x4 (&acc)[2][2][4][2], const Unit& u, int wr, int wc, int fr, int fq) const {
        const int row0 = u.pm * BM + wr * 64 + fr, col0 = u.pn * BM + wc * 32 + 8 * fq;
        const bool isq = u.pn * BM < 2048; const float* gp = isq ? gq : gk; const float fold = isq ? qscale : 1.0f;
#pragma unroll
        for (int ai = 0; ai < 2; ++ai)
#pragma unroll
            for (int m = 0; m < 4; ++m) { const int lrow = ai * HALF + wr * 64 + m * 16 + fr; const float rs = rs_from_ssq(sq2f(ssq_in[u.pm * BM + lrow]), 1.0f / 2048.0f);
#pragma unroll
                for (int bj = 0; bj < 2; ++bj) { const f32x4 v0 = acc[ai][bj][m][0] * rs, v1 = acc[ai][bj][m][1] * rs;
                    float s = sq4(v0) + sq4(v1); s += __shfl_xor(s, 16); s += __shfl_xor(s, 32);
                    if (fq == 0) xq[(lrow * 2 + bj) * 4 + wc] = s; } }
#ifndef NOXCH
        asm volatile("s_waitcnt lgkmcnt(0)" ::: "memory"); __builtin_amdgcn_s_barrier(); asm volatile("" ::: "memory");
#endif
        const float inv_hd = hd == 128 ? (1.0f / 128.0f) : (1.0f / 64.0f);
#pragma unroll
        for (int ai = 0; ai < 2; ++ai)
#pragma unroll
            for (int m = 0; m < 4; ++m) { const int lrow = ai * HALF + wr * 64 + m * 16 + fr; const int row = u.pm * BM + lrow; const float rsrow = rs_from_ssq(sq2f(ssq_in[row]), 1.0f / 2048.0f) * fold;
#pragma unroll
                for (int bj = 0; bj < 2; ++bj) { const f32x4 pr = *(const PG8_LAS f32x4*)(xq + (lrow * 2 + bj) * 4);
                    const int d0 = (bj * HALF + wc * 32 + 8 * fq) & (hd - 1); const f32x4 g0 = *(const f32x4*)(gp + d0), g1 = *(const f32x4*)(gp + d0 + 4);
#ifdef NOXCH
                    const float tot = 64.0f; (void)pr;
#else
                    const float tot = hd == 128 ? ((pr[0] + pr[1]) + (pr[2] + pr[3])) : ((wc & 2) ? (pr[2] + pr[3]) : (pr[0] + pr[1]));
#endif
                    const float rn = __builtin_amdgcn_rsqf(tot * inv_hd + RMS_EPS) * rsrow;
                    *(u32x4*)(O + (size_t)row * ldc + col0 + bj * HALF) = pack8(acc[ai][bj][m][0] * rn * g0, acc[ai][bj][m][1] * rn * g1); }
                asm volatile("" ::: "memory"); }
    }
};
struct EpiVt {
    static constexpr bool PERM = true, AFTER_DRAIN = false;
    bf16_t* O; int ldc; const sq_t* ssq_in;
    __device__ __forceinline__ void operator()(const f32x4 (&acc)[2][2][4][2], const Unit& u, int wr, int wc, int fr, int fq) const {
        const int row0 = u.pm * BM + wr * 64 + fr, col0 = u.pn * BM + wc * 32 + 8 * fq;
        f32x4 rs[2][2];
#pragma unroll
        for (int bj = 0; bj < 2; ++bj)
#pragma unroll
            for (int n = 0; n < 2; ++n) { const sq_t* q = ssq_in + col0 + bj * HALF + 4 * n;
                rs[bj][n] = (f32x4){rs_from_ssq(sq2f(q[0]), 1.0f / 2048.0f), rs_from_ssq(sq2f(q[1]), 1.0f / 2048.0f), rs_from_ssq(sq2f(q[2]), 1.0f / 2048.0f), rs_from_ssq(sq2f(q[3]), 1.0f / 2048.0f)}; }
#pragma unroll
        for (int ai = 0; ai < 2; ++ai)
#pragma unroll
            for (int m = 0; m < 4; ++m) { const int row = row0 + ai * HALF + m * 16;
#pragma unroll
                for (int bj = 0; bj < 2; ++bj) *(u32x4*)(O + (size_t)row * ldc + col0 + bj * HALF) = pack8(acc[ai][bj][m][0] * rs[bj][0], acc[ai][bj][m][1] * rs[bj][1]); }
    }
};
struct EpiRes {
    static constexpr bool PERM = true, AFTER_DRAIN = false;
    const bf16_t* hin; bf16_t* hb; sq_t* ssq_out;
    __device__ __forceinline__ void operator()(const f32x4 (&acc)[2][2][4][2], const Unit& u, int wr, int wc, int fr, int fq) const {
        const int row0 = u.pm * BM + wr * 64 + fr, col0 = u.pn * BM + wc * 32 + 8 * fq;
#pragma unroll
        for (int ai = 0; ai < 2; ++ai)
#pragma unroll
            for (int m = 0; m < 4; ++m) { const int row = row0 + ai * HALF + m * 16; const size_t off = (size_t)row * 2048 + col0; float s = 0.f;
#pragma unroll
                for (int bj = 0; bj < 2; ++bj) { const u32x4 hr = *(const u32x4*)(hin + off + bj * HALF);
                    const f32x4 v0 = acc[ai][bj][m][0] + (f32x4){bflo(hr.x), bfhi(hr.x), bflo(hr.y), bfhi(hr.y)}, v1 = acc[ai][bj][m][1] + (f32x4){bflo(hr.z), bfhi(hr.z), bflo(hr.w), bfhi(hr.w)};
                    *(u32x4*)(hb + off + bj * HALF) = pack8(v0, v1); s += sq4(v0) + sq4(v1); }
                s += __shfl_xor(s, 16); s += __shfl_xor(s, 32);
                if (fq == 0) atomicAdd(ssq_out + row, f2sq(s)); }
    }
};
struct EpiSwiGLU {
    static constexpr bool PERM = true, AFTER_DRAIN = false;
    bf16_t* O; const sq_t* ssq_in;
    __device__ __forceinline__ void operator()(const f32x4 (&acc)[2][2][4][2], const Unit& u, int wr, int wc, int fr, int fq) const {
        const int row0 = u.pm * BM + wr * 64 + fr, col0 = u.pn * HALF + wc * 32 + 8 * fq;
#pragma unroll
        for (int ai = 0; ai < 2; ++ai)
#pragma unroll
            for (int m = 0; m < 4; ++m) { const int row = row0 + ai * HALF + m * 16; const float rs = rs_from_ssq(sq2f(ssq_in[row]), 1.0f / 2048.0f);
                f32x4 o[2];
#pragma unroll
                for (int n = 0; n < 2; ++n) { const f32x4 g = acc[ai][0][m][n] * rs, uu = acc[ai][1][m][n] * rs;
#pragma unroll
                    for (int e = 0; e < 4; ++e) o[n][e] = g[e] * sigmoid_f(g[e]) * uu[e]; }
                *(u32x4*)(O + (size_t)row * 5632 + col0) = pack8(o[0], o[1]); }
    }
};
struct EpiPP {
    static constexpr bool PERM = true, AFTER_DRAIN = false;
    bf16_t* O; sq_t* ssq_out;
    __device__ __forceinline__ void operator()(const f32x4 (&acc)[2][2][4][2], const Unit& u, int wr, int wc, int fr, int fq) const {
        const int row0 = u.pm * BM + wr * 64 + fr, col0 = u.pn * BM + wc * 32 + 8 * fq;
#pragma unroll
        for (int ai = 0; ai < 2; ++ai)
#pragma unroll
            for (int m = 0; m < 4; ++m) { const int row = row0 + ai * HALF + m * 16; const size_t off = (size_t)row * 2048 + col0; float s = 0.f;
#pragma unroll
                for (int bj = 0; bj < 2; ++bj) { *(u32x4*)(O + off + bj * HALF) = pack8(acc[ai][bj][m][0], acc[ai][bj][m][1]); s += sq4(acc[ai][bj][m][0]) + sq4(acc[ai][bj][m][1]); }
                s += __shfl_xor(s, 16); s += __shfl_xor(s, 32);
                if (fq == 0) atomicAdd(ssq_out + row, f2sq(s)); }
    }
};
struct EpiPLE {
    static constexpr bool PERM = true, AFTER_DRAIN = false;
    const bf16_t* hin; float* hout; bf16_t* hb; sq_t* ssq_out; const sq_t* ssq_h; const sq_t* ssq_pp; const bf16_t* PP; const float* post;
    __device__ __forceinline__ void operator()(const f32x4 (&acc)[2][2][4][2], const Unit& u, int wr, int wc, int fr, int fq) const {
        const int row0 = u.pm * BM + wr * 64 + fr, col0 = u.pn * BM + wc * 32 + 8 * fq;
        f32x4 pw[2][2];
#pragma unroll
        for (int bj = 0; bj < 2; ++bj)
#pragma unroll
            for (int n = 0; n < 2; ++n) pw[bj][n] = *(const f32x4*)(post + col0 + bj * HALF + 4 * n);
#pragma unroll
        for (int ai = 0; ai < 2; ++ai)
#pragma unroll
            for (int m = 0; m < 4; ++m) { const int row = row0 + ai * HALF + m * 16; const size_t off = (size_t)row * 2048 + col0; float s = 0.f;
                const float rh = rs_from_ssq(sq2f(ssq_h[row]), 1.0f / 2048.0f), rp = rs_from_ssq(sq2f(ssq_pp[row]), 1.0f / 2048.0f);
#pragma unroll
                for (int bj = 0; bj < 2; ++bj) { const u32x4 hr = *(const u32x4*)(hin + off + bj * HALF);
                    const f32x4 h0 = (f32x4){bflo(hr.x), bfhi(hr.x), bflo(hr.y), bfhi(hr.y)}, h1 = (f32x4){bflo(hr.z), bfhi(hr.z), bflo(hr.w), bfhi(hr.w)};
                    const u32x4 pr = *(const u32x4*)(PP + off + bj * HALF);
                    const f32x4 p0 = (f32x4){bflo(pr.x), bfhi(pr.x), bflo(pr.y), bfhi(pr.y)}, p1 = (f32x4){bflo(pr.z), bfhi(pr.z), bflo(pr.w), bfhi(pr.w)};
                    f32x4 v0, v1;
#pragma unroll
                    for (int e = 0; e < 4; ++e) { v0[e] = h0[e] + p0[e] * rp * pw[bj][0][e] * sigmoid_f(acc[ai][bj][m][0][e] * rh); v1[e] = h1[e] + p1[e] * rp * pw[bj][1][e] * sigmoid_f(acc[ai][bj][m][1][e] * rh); }
                    if (hout) { *(f32x4*)(hout + off + bj * HALF) = v0; *(f32x4*)(hout + off + bj * HALF + 4) = v1; }
                    if (hb) { *(u32x4*)(hb + off + bj * HALF) = pack8(v0, v1); s += sq4(v0) + sq4(v1); } }
                if (hb) { s += __shfl_xor(s, 16); s += __shfl_xor(s, 32); if (fq == 0) atomicAdd(ssq_out + row, f2sq(s)); } }
    }
};
template <class Epi, class Sched, bool ALIGN_EPI = false, bool SP2 = false>
__device__ __forceinline__ void gemm_phase(PG8_LAS unsigned char* lds, const Gemm g, const Sched& S, const Epi& E) {
    int tid_ = TIDX; asm volatile("" : "+v"(tid_));
    const int tid = tid_, wid = __builtin_amdgcn_readfirstlane(tid >> 6), lane = tid & 63, wr = wid >> 2, wc = wid & 3, fr = lane & 15, fq = lane >> 4;
    const int K = g.K, nt = K / BK;
    unsigned voffA[2], voffB[2];
#pragma unroll
    for (int i = 0; i < 2; ++i) { int R, C; stage_rc(tid * 16 + i * 8192, R, C); const int Rb = Epi::PERM ? ((R & ~31) + perm32(R & 31)) : R;
        voffA[i] = (unsigned)(R * K + C) * 2u; voffB[i] = (unsigned)(Rb * K + C) * 2u; }
    const size_t kstep = (size_t)(BK * 2);
    const size_t hstep = (size_t)HALF * K * 2;
    const size_t tstep = 2 * hstep;
    const unsigned ldsw = (unsigned)wid * 1024u;
    const int aoff = lds_byte(wr * 64 + fr, fq * 8), boff = lds_byte(wc * 32 + fr, fq * 8);
#define PG8_SA(b, h) (((b) * 2 + (h)) * HTB)
#define PG8_SB(b, h) ((4 + (b) * 2 + (h)) * HTB)
#define PG8_STAGE(bufoff, gbase, voff) do { _Pragma("unroll") for (int _i = 0; _i < 2; ++_i) \
        __builtin_amdgcn_global_load_lds((const unsigned*)((const char*)(gbase) + (voff)[_i]), (PG8_LAS unsigned*)(lds + (bufoff) + ldsw + _i * 8192), 16, 0, 0); } while (0)
#define PG8_LDA(dst, b, h) do { _Pragma("unroll") for (int m = 0; m < 4; ++m) _Pragma("unroll") for (int k = 0; k < 2; ++k) dst[m][k] = *(const PG8_LAS bf16x8*)(lds + PG8_SA(b, h) + aoff + m * 2048 + k * 1024); } while (0)
#define PG8_LDB(dst, b, h) do { _Pragma("unroll") for (int n = 0; n < 2; ++n) _Pragma("unroll") for (int k = 0; k < 2; ++k) dst[n][k] = *(const PG8_LAS bf16x8*)(lds + PG8_SB(b, h) + boff + n * 2048 + k * 1024); } while (0)
#define PG8_MMA(ai, bj, At, Bt) do { __builtin_amdgcn_s_setprio(1); _Pragma("unroll") for (int m = 0; m < 4; ++m) _Pragma("unroll") for (int n = 0; n < 2; ++n) _Pragma("unroll") for (int k = 0; k < 2; ++k) \
        acc[ai][bj][m][n] = __builtin_amdgcn_mfma_f32_16x16x32_bf16(Bt[n][k], At[m][k], acc[ai][bj][m][n], 0, 0, 0); __builtin_amdgcn_s_setprio(0); } while (0)
#define PG8_WAIT_V(n) asm volatile("s_waitcnt vmcnt(" #n ")" ::: "memory")
#define PG8_WAIT_L(n) asm volatile("s_waitcnt lgkmcnt(" #n ")" ::: "memory")
#define PG8_BAR __builtin_amdgcn_s_barrier()
#define PG8_SCHED __builtin_amdgcn_sched_barrier(0)
    Unit cur, nxt; int ui = 0;
    if (!S.next(0, cur)) return;
    f32x4 acc[2][2][4][2];
#pragma unroll
    for (int a = 0; a < 2; ++a)
#pragma unroll
        for (int b = 0; b < 2; ++b)
#pragma unroll
            for (int m = 0; m < 4; ++m)
#pragma unroll
                for (int n = 0; n < 2; ++n) acc[a][b][m][n] = (f32x4){0.f, 0.f, 0.f, 0.f};
    bf16x8 At[4][2], B0[2][2], B1[2][2];
    const char* cA = (const char*)g.A + (size_t)cur.pm * tstep; const char* cB = (const char*)g.Bt + (size_t)cur.pn * tstep;
    S.a_ready(cur);
    if constexpr (SP2) {
        PG8_STAGE(PG8_SB(0, 0), cB, voffB); PG8_STAGE(PG8_SB(0, 1), cB + hstep, voffB); PG8_STAGE(PG8_SA(0, 0), cA, voffA); PG8_STAGE(PG8_SA(0, 1), cA + hstep, voffA);
        if (wr == 1) PG8_BAR;
        PG8_WAIT_V(2); PG8_BAR;
        PG8_STAGE(PG8_SB(1, 0), cB + kstep, voffB); PG8_STAGE(PG8_SA(1, 0), cA + kstep, voffA); PG8_STAGE(PG8_SB(1, 1), cB + hstep + kstep, voffB);
        PG8_WAIT_V(6); PG8_BAR;
    } else {
        PG8_STAGE(PG8_SB(0, 0), cB, voffB); PG8_STAGE(PG8_SA(0, 0), cA, voffA); PG8_STAGE(PG8_SB(0, 1), cB + hstep, voffB); PG8_STAGE(PG8_SA(0, 1), cA + hstep, voffA);
        if (wr == 1) PG8_BAR;
        PG8_WAIT_V(4); PG8_BAR;
        PG8_STAGE(PG8_SB(1, 0), cB + kstep, voffB); PG8_STAGE(PG8_SA(1, 0), cA + kstep, voffA); PG8_STAGE(PG8_SB(1, 1), cB + hstep + kstep, voffB);
        PG8_WAIT_V(6); PG8_BAR;
    }
    for (;;) {
        const bool has_next = S.next(ui + 1, nxt);
        const char* nA = has_next ? (const char*)g.A + (size_t)nxt.pm * tstep : cA; const char* nB = has_next ? (const char*)g.Bt + (size_t)nxt.pn * tstep : cB;
        for (int t = 0; t < nt; t += 2) {
            const bool last = (t == nt - 2);
            const char* a1 = cA + (size_t)(t + 1) * kstep;
            const char* a2 = last ? nA : cA + (size_t)(t + 2) * kstep; const char* b2 = last ? nB : cB + (size_t)(t + 2) * kstep;
            const char* a3 = a2 + kstep; const char* b3 = b2 + kstep;
            if (last && has_next) S.a_ready(nxt);
            if constexpr (SP2) {
            PG8_LDB(B0, 0, 0); PG8_LDB(B1, 0, 1); PG8_SCHED; PG8_LDA(At, 0, 0); PG8_STAGE(PG8_SA(1, 1), a1 + hstep, voffA);
            PG8_WAIT_V(8); PG8_WAIT_L(0); PG8_BAR; PG8_MMA(0, 0, At, B0); PG8_MMA(0, 1, At, B1); PG8_BAR; PG8_SCHED;
            PG8_LDA(At, 0, 1); PG8_STAGE(PG8_SB(0, 0), b2, voffB); PG8_STAGE(PG8_SB(0, 1), b2 + hstep, voffB); PG8_STAGE(PG8_SA(0, 0), a2, voffA);
            PG8_WAIT_V(8); PG8_WAIT_L(0); PG8_BAR; PG8_MMA(1, 0, At, B0); PG8_MMA(1, 1, At, B1); PG8_BAR; PG8_SCHED;
            PG8_LDB(B0, 1, 0); PG8_LDB(B1, 1, 1); PG8_SCHED; PG8_LDA(At, 1, 0); PG8_STAGE(PG8_SA(0, 1), a2 + hstep, voffA);
            PG8_WAIT_V(8); PG8_WAIT_L(0); PG8_BAR; PG8_MMA(0, 0, At, B0); PG8_MMA(0, 1, At, B1); PG8_BAR; PG8_SCHED;
            PG8_LDA(At, 1, 1); PG8_STAGE(PG8_SB(1, 0), b3, voffB); PG8_STAGE(PG8_SB(1, 1), b3 + hstep, voffB); PG8_STAGE(PG8_SA(1, 0), a3, voffA);
            PG8_WAIT_V(8); PG8_WAIT_L(0); PG8_BAR; PG8_MMA(1, 0, At, B0); PG8_MMA(1, 1, At, B1); PG8_BAR; PG8_SCHED;
            } else {
            PG8_LDB(B0, 0, 0); PG8_SCHED; PG8_LDA(At, 0, 0); PG8_STAGE(PG8_SA(1, 1), a1 + hstep, voffA);
            PG8_WAIT_L(8); PG8_BAR; PG8_WAIT_L(0); PG8_MMA(0, 0, At, B0); PG8_BAR; PG8_SCHED;
            PG8_LDB(B1, 0, 1); PG8_STAGE(PG8_SB(0, 0), b2, voffB);
            PG8_BAR; PG8_WAIT_L(0); PG8_MMA(0, 1, At, B1); PG8_BAR;
            PG8_LDA(At, 0, 1); PG8_STAGE(PG8_SA(0, 0), a2, voffA);
            PG8_BAR; PG8_WAIT_L(0); PG8_MMA(1, 0, At, B0); PG8_BAR; PG8_SCHED;
            PG8_STAGE(PG8_SB(0, 1), b2 + hstep, voffB);
            PG8_WAIT_V(6); PG8_BAR; PG8_MMA(1, 1, At, B1); PG8_BAR;
            PG8_LDB(B0, 1, 0); PG8_SCHED; PG8_LDA(At, 1, 0); PG8_STAGE(PG8_SA(0, 1), a2 + hstep, voffA);
            PG8_WAIT_L(8); PG8_BAR; PG8_WAIT_L(0); PG8_MMA(0, 0, At, B0); PG8_BAR; PG8_SCHED;
            PG8_LDB(B1, 1, 1); PG8_STAGE(PG8_SB(1, 0), b3, voffB);
            PG8_BAR; PG8_WAIT_L(0); PG8_MMA(0, 1, At, B1); PG8_BAR;
            PG8_LDA(At, 1, 1); PG8_STAGE(PG8_SA(1, 0), a3, voffA);
            PG8_BAR; PG8_WAIT_L(0); PG8_MMA(1, 0, At, B0); PG8_BAR; PG8_SCHED;
            PG8_STAGE(PG8_SB(1, 1), b3 + hstep, voffB);
            PG8_WAIT_V(6); PG8_BAR; PG8_MMA(1, 1, At, B1); PG8_BAR;
            }
        }
        if constexpr (ALIGN_EPI) { if (wr == 0) PG8_BAR; }
        if constexpr (!Epi::AFTER_DRAIN) { E(acc, cur, wr, wc, fr, fq); S.done(cur); }
        if (!has_next) break;
#pragma unroll
        for (int a = 0; a < 2; ++a)
#pragma unroll
            for (int b = 0; b < 2; ++b)
#pragma unroll
                for (int m = 0; m < 4; ++m)
#pragma unroll
                    for (int n = 0; n < 2; ++n) acc[a][b][m][n] = (f32x4){0.f, 0.f, 0.f, 0.f};
        cur = nxt; cA = nA; cB = nB; ++ui;
        if constexpr (ALIGN_EPI) { if (wr == 1) PG8_BAR; }
    }
    PG8_WAIT_V(0);
    if constexpr (!ALIGN_EPI) { if (wr == 0) PG8_BAR; }
    PG8_BAR;
    if constexpr (Epi::AFTER_DRAIN) { E.fused(acc, cur, wr, wc, fr, fq, lds, wid, lane); S.done(cur); }
#undef PG8_SA
#undef PG8_SB
#undef PG8_STAGE
#undef PG8_LDA
#undef PG8_LDB
#undef PG8_MMA
#undef PG8_WAIT_V
#undef PG8_WAIT_L
#undef PG8_BAR
#undef PG8_SCHED
}
}

#define LAS __attribute__((address_space(3)))
typedef unsigned short bf16;
typedef unsigned u32x4 __attribute__((ext_vector_type(4)));
typedef unsigned u32x2 __attribute__((ext_vector_type(2)));
typedef float f32x4 __attribute__((ext_vector_type(4)));
typedef float f32x16 __attribute__((ext_vector_type(16)));
typedef short bf16x8 __attribute__((ext_vector_type(8)));
constexpr float LOG2E = 1.4426950408889634f;
constexpr float EPS = 1e-6f;
__device__ __forceinline__ float wave_sum(float v) {
#pragma unroll
    for (int o = 1; o < 64; o <<= 1) v += __shfl_xor(v, o);
    return v;
}
__device__ __forceinline__ float wave_max(float v) {
#pragma unroll
    for (int o = 1; o < 64; o <<= 1) v = fmaxf(v, __shfl_xor(v, o));
    return v;
}
__device__ __forceinline__ unsigned pk2(float lo, float hi) { return pg8::cvt_pk_bf16(lo, hi); }
__device__ __forceinline__ float bflo(unsigned w) { return __uint_as_float(w << 16); }
__device__ __forceinline__ float bfhi(unsigned w) { return __uint_as_float(w & 0xffff0000u); }
__device__ __forceinline__ int swap23(int r) { return (r & ~12) | ((r & 4) << 1) | ((r & 8) >> 1); }
__device__ __forceinline__ bf16x8 scale_frag(const u32x4 raw, const float s, const LAS float* gg) {
    const f32x4 g0 = *(const LAS f32x4*)gg, g1 = *(const LAS f32x4*)(gg + 4);
    u32x4 w;
    w.x = pk2(bflo(raw.x) * s * g0[0], bfhi(raw.x) * s * g0[1]); w.y = pk2(bflo(raw.y) * s * g0[2], bfhi(raw.y) * s * g0[3]);
    w.z = pk2(bflo(raw.z) * s * g1[0], bfhi(raw.z) * s * g1[1]); w.w = pk2(bflo(raw.w) * s * g1[2], bfhi(raw.w) * s * g1[3]);
    return __builtin_bit_cast(bf16x8, w);
}
#define MFMA32(a, b, c) __builtin_amdgcn_mfma_f32_32x32x16_bf16((a), (b), (c), 0, 0, 0)

#define XB_TMO      128
#define XB_XCNT(j)  (256  + 64 * (j))
#define XB_XSUB(j)  (1280 + 64 * (j))
#define XB_XGEN(j)  (2304 + 64 * (j))
#define XB_TOP      3328
#define XB_TOPGEN   3392
#define XCD_BAR_WORDS 3456
#define XB_SPIN_CAP (1u << 18)

__device__ __forceinline__ unsigned xb_ld(unsigned* p)              { return __hip_atomic_load(p, __ATOMIC_RELAXED, __HIP_MEMORY_SCOPE_AGENT); }
__device__ __forceinline__ unsigned xb_add(unsigned* p, unsigned v) { return __hip_atomic_fetch_add(p, v, __ATOMIC_RELAXED, __HIP_MEMORY_SCOPE_AGENT); }
__device__ __forceinline__ unsigned xb_xcc_id() { return (unsigned)__builtin_amdgcn_s_getreg((3 << 11) | 20) & 0xFu; }
#define XB_SPIN(cond, bar) do { unsigned _sp = 0; while (cond) { __builtin_amdgcn_s_sleep(1); \
    if ((++_sp & 255u) == 0u) { if (xb_ld(&(bar)[XB_TMO])) break; if (_sp > XB_SPIN_CAP) { atomicAdd(&(bar)[XB_TMO], 1u); break; } } } } while (0)

struct XcdBarrier {
    unsigned* bar; unsigned x;
    volatile LAS unsigned* st;
};

__device__ __forceinline__ XcdBarrier xcd_barrier_post(unsigned* bar, volatile LAS unsigned* st) {
    XcdBarrier b; b.bar = bar; b.x = xb_xcc_id(); b.st = st;
    if (TIDX == 0) (void)xb_add(&bar[XB_XCNT(b.x)], 1u);
    return b;
}
__device__ __forceinline__ void xcd_barrier_complete(unsigned* bar, unsigned x, unsigned& nloc, unsigned& nx) {
    const unsigned G = gridDim.x * gridDim.y * gridDim.z;
    unsigned sum, cnt, mine, sp = 0u;
    for (;;) {
        sum = 0u; cnt = 0u; mine = 0u;
#pragma unroll
        for (unsigned j = 0; j < 16; ++j) { const unsigned c = xb_ld(&bar[XB_XCNT(j)]); sum += c; cnt += (c > 0u) ? 1u : 0u; mine = (j == x) ? c : mine; }
        if (sum == G) break;
        __builtin_amdgcn_s_sleep(1);
        if ((++sp & 255u) == 0u) { if (xb_ld(&bar[XB_TMO])) break; if (sp > XB_SPIN_CAP) { atomicAdd(&bar[XB_TMO], 1u); break; } }
    }
    nloc = mine > 0u ? mine : 1u; nx = cnt > 0u ? cnt : 1u;
}

__device__ __forceinline__ void xcd_barrier(const XcdBarrier& b) {
    asm volatile("s_waitcnt vmcnt(0)" ::: "memory");
    __syncthreads();
    if (TIDX == 0) {
        unsigned* bar = b.bar;
        __builtin_amdgcn_s_waitcnt(0);
        unsigned nloc = b.st[0], nx = b.st[1];
        if (nloc == 0u) { xcd_barrier_complete(bar, b.x, nloc, nx); b.st[0] = nloc; b.st[1] = nx; }
        const unsigned old = xb_add(&bar[XB_XSUB(b.x)], 1u);
        const unsigned gen = old / nloc;
        if (old + 1u == (gen + 1u) * nloc) {
            __builtin_amdgcn_fence(__ATOMIC_RELEASE, "agent");
            asm volatile("s_waitcnt vmcnt(0)" ::: "memory");
            const unsigned og = xb_add(&bar[XB_TOP], 1u);
            const unsigned tg = og / nx;
            if (og + 1u == (tg + 1u) * nx) xb_add(&bar[XB_TOPGEN], 1u);
            else XB_SPIN(xb_ld(&bar[XB_TOPGEN]) == tg, bar);
            __builtin_amdgcn_fence(__ATOMIC_ACQUIRE, "agent");
            xb_add(&bar[XB_XGEN(b.x)], 1u);
            asm volatile("s_waitcnt vmcnt(0)" ::: "memory");
        } else {
            XB_SPIN(xb_ld(&bar[XB_XGEN(b.x)]) == gen, bar);
            __builtin_amdgcn_fence(__ATOMIC_ACQUIRE, "agent");
            asm volatile("s_waitcnt vmcnt(0)" ::: "memory");
        }
    }
    __syncthreads();
}

constexpr int BATCH = 8, SEQ = 2048, DM = 2048, MTOK = BATCH * SEQ, DFF = 5632, PLE = 256;
constexpr int A_NQK = 2304, A_NV = 256, B_NQK = 4096, B_NV = 2048;

__device__ __forceinline__ void attnA_phase(LAS unsigned char* lds, const bf16* qk, const bf16* Vt, bf16* ao, const float* gq, const float* gk, const float* sink) {
    constexpr int LDQ = A_NQK, KROW = 144, VROW = 784;
    constexpr int OFF_K = 0, OFF_V = 384 * KROW;
    const int tid = TIDX, lane = tid & 63, wid = __builtin_amdgcn_readfirstlane(tid >> 6), r32 = lane & 31, hi = lane >> 5;
    constexpr float SC2 = 0.125f * LOG2E;
    const float Mb2 = 64.0f * wave_max(fabsf(gq[lane])) * wave_max(fabsf(gk[lane])) * SC2;
    const int vcu = (gridDim.x & 7) == 0 ? (blockIdx.x & 7) * (gridDim.x >> 3) + (blockIdx.x >> 3) : blockIdx.x;
    for (int unit = vcu; unit < BATCH * 4 * 16; unit += gridDim.x) {
        const int n = unit & 15, kv = (unit >> 4) & 3, b = unit >> 6;
        const int start = n * 128, s0 = start - 128, rowbase = b * SEQ;
        __syncthreads();
#pragma unroll
        for (int i = 0; i < 6; ++i) { const int c = tid + i * 512, row = c >> 3, ch = c & 7, s = s0 + row; u32x4 v = (u32x4){0u, 0u, 0u, 0u};
            if (s >= 0 && s < SEQ) v = *(const u32x4*)(qk + (size_t)(rowbase + s) * LDQ + 2048 + kv * 64 + ch * 8);
            *(LAS u32x4*)(lds + OFF_K + row * KROW + ch * 16) = v; }
#pragma unroll
        for (int i = 0; i < 6; ++i) { const int c = tid + i * 512, d = c / 48, ch = c % 48, s = s0 + ch * 8; u32x4 v = (u32x4){0u, 0u, 0u, 0u};
            if (s >= 0 && s < SEQ) v = *(const u32x4*)(Vt + (size_t)(kv * 64 + d) * MTOK + rowbase + s);
            *(LAS u32x4*)(lds + OFF_V + d * VROW + ch * 16) = v; }
        __syncthreads();
        const int h = kv * 8 + wid;
        const float slope2 = exp2f(-8.0f * (float)(h + 1) / 32.0f) * LOG2E;
        const float sinkterm = exp2f(sink[h] * LOG2E - Mb2);
        for (int j = 0; j < 4; ++j) {
            const int t = start + 32 * j + r32, tok = rowbase + t;
            bf16x8 qf[4];
#pragma unroll
            for (int kk = 0; kk < 4; ++kk) qf[kk] = *(const bf16x8*)(qk + (size_t)tok * LDQ + h * 64 + kk * 16 + hi * 8);
            f32x16 o0 = {}, o1 = {}; float l = 0.f;
            for (int kt = j; kt < j + 9; ++kt) {
                const int sb = s0 + 32 * kt;
                if (sb < 0 || sb >= SEQ) continue;
                const LAS unsigned char* kb = lds + OFF_K + (32 * kt + swap23(r32)) * KROW + hi * 16;
                const LAS unsigned char* vb = lds + OFF_V + r32 * VROW + (32 * kt) * 2 + hi * 16;
                bf16x8 kf[4], vf[4];
#pragma unroll
                for (int kk = 0; kk < 4; ++kk) kf[kk] = *(const LAS bf16x8*)(kb + kk * 32);
                vf[0] = *(const LAS bf16x8*)(vb); vf[1] = *(const LAS bf16x8*)(vb + 32); vf[2] = *(const LAS bf16x8*)(vb + 32 * VROW); vf[3] = *(const LAS bf16x8*)(vb + 32 * VROW + 32);
                const float tf = (float)(t - (sb + 8 * hi));
                f32x16 sacc;
#pragma unroll
                for (int r = 0; r < 16; ++r) sacc[r] = 0.f;
#pragma unroll
                for (int kk = 0; kk < 4; ++kk) sacc = MFMA32(kf[kk], qf[kk], sacc);
                float p[16];
#pragma unroll
                for (int r = 0; r < 16; ++r) { const float dist = fabsf(tf - (float)(16 * (r >> 3) + (r & 7)));
                    const float e = __builtin_amdgcn_exp2f(sacc[r] - slope2 * dist - Mb2); p[r] = (dist <= 128.0f) ? e : 0.f; l += p[r]; }
                u32x4 w0, w1;
                w0.x = pk2(p[0], p[1]); w0.y = pk2(p[2], p[3]); w0.z = pk2(p[4], p[5]); w0.w = pk2(p[6], p[7]);
                w1.x = pk2(p[8], p[9]); w1.y = pk2(p[10], p[11]); w1.z = pk2(p[12], p[13]); w1.w = pk2(p[14], p[15]);
                const bf16x8 pa0 = __builtin_bit_cast(bf16x8, w0), pa1 = __builtin_bit_cast(bf16x8, w1);
                o0 = MFMA32(vf[0], pa0, o0); o1 = MFMA32(vf[2], pa0, o1); o0 = MFMA32(vf[1], pa1, o0); o1 = MFMA32(vf[3], pa1, o1);
            }
            l += __shfl_xor(l, 32); l += sinkterm;
            const float inv = 1.0f / l;
            bf16* op = ao + (size_t)tok * DM + h * 64 + 4 * hi;
#pragma unroll
            for (int gp = 0; gp < 2; ++gp) {
                u32x2 pa[2], pb[2];
#pragma unroll
                for (int e = 0; e < 2; ++e) { const int g4 = 2 * gp + e;
                    pa[e].x = pk2(o0[4 * g4] * inv, o0[4 * g4 + 1] * inv); pa[e].y = pk2(o0[4 * g4 + 2] * inv, o0[4 * g4 + 3] * inv);
                    pb[e].x = pk2(o1[4 * g4] * inv, o1[4 * g4 + 1] * inv); pb[e].y = pk2(o1[4 * g4 + 2] * inv, o1[4 * g4 + 3] * inv); }
                const auto ax = __builtin_amdgcn_permlane32_swap(pa[0].x, pa[1].x, false, false), ay = __builtin_amdgcn_permlane32_swap(pa[0].y, pa[1].y, false, false);
                const auto bx = __builtin_amdgcn_permlane32_swap(pb[0].x, pb[1].x, false, false), by = __builtin_amdgcn_permlane32_swap(pb[0].y, pb[1].y, false, false);
                u32x4 wa, wb; wa.x = ax[0]; wa.y = ay[0]; wa.z = ax[1]; wa.w = ay[1]; wb.x = bx[0]; wb.y = by[0]; wb.z = bx[1]; wb.w = by[1];
                *(u32x4*)(op - 4 * hi + 16 * gp + 8 * hi) = wa; *(u32x4*)(op - 4 * hi + 32 + 16 * gp + 8 * hi) = wb; }
        }
    }
}

constexpr int B_KT = 64 * 256, B_VT = 256 * 128;
constexpr int B_NKS = 3, B_NVS = 2;
constexpr int B_OFF_K = 0, B_OFF_V = B_NKS * B_KT, B_OFF_P = B_OFF_V + B_NVS * B_VT, B_OFF_XCH = B_OFF_P + 2 * 8 * 2048, B_LDS_END = B_OFF_XCH + 1024;
#define GLDS16(g, l) __builtin_amdgcn_global_load_lds((const __attribute__((address_space(1))) unsigned*)(g), (LAS unsigned*)(l), 16, 0, 0)
#define B_WAITV(n) asm volatile("s_waitcnt vmcnt(" #n ")" ::: "memory")
struct BCtx {
    const bf16* ksrc; const bf16* vsrc; int kdelta, vdelta, kro, kx2, vro, vx2, t;
};
__device__ __forceinline__ void b_issue_k(LAS unsigned char* lds, const BCtx& c, int wid, int kt, int slot) {
    GLDS16(c.ksrc + (size_t)(64 * kt) * B_NQK, lds + B_OFF_K + slot * B_KT + wid * 2048);
    GLDS16(c.ksrc + (size_t)(64 * kt + 4) * B_NQK + c.kdelta, lds + B_OFF_K + slot * B_KT + wid * 2048 + 1024);
}
__device__ __forceinline__ void b_issue_v(LAS unsigned char* lds, const BCtx& c, int wid, int kt, int slot) {
#pragma unroll
    for (int i = 0; i < 4; ++i) GLDS16(c.vsrc + (size_t)(8 * i) * MTOK + 64 * kt + ((i & 1) ? c.vdelta : 0), lds + B_OFF_V + slot * B_VT + wid * 4096 + i * 1024);
}
__device__ __forceinline__ void b_scores(LAS unsigned char* lds, const BCtx& c, const bf16x8 (&qf)[8], int kslot, int st, int kt, int t, int hi, float slope2, float Mb2, float (&p)[16], float& l) {
    const LAS unsigned char* kb = lds + B_OFF_K + kslot * B_KT + st * 32 * 256 + c.kro;
    f32x16 sacc = {};
#pragma unroll
    for (int half = 0; half < 2; ++half) {
        bf16x8 kf[4];
#pragma unroll
        for (int kk = 0; kk < 4; ++kk) kf[kk] = *(const LAS bf16x8*)(kb + (((4 * half + kk) * 32) ^ c.kx2));
        __builtin_amdgcn_sched_barrier(0);
#pragma unroll
        for (int kk = 0; kk < 4; ++kk) sacc = MFMA32(kf[kk], qf[4 * half + kk], sacc);
        __builtin_amdgcn_sched_barrier(0);
    }
    const float tf = (float)(t - (64 * kt + 32 * st + 8 * hi));
#pragma unroll
    for (int r = 0; r < 16; ++r) { p[r] = __builtin_amdgcn_exp2f(sacc[r] + (-slope2 * fabsf(tf - (float)(16 * (r >> 3) + (r & 7))) - Mb2)); l += p[r]; }
}
__device__ __forceinline__ float attnB_pass0(LAS unsigned char* lds, const BCtx& c, const bf16x8 (&qf)[8], int t, float slope2, float Mb2, int dh) {
    constexpr int NT = SEQ / 64;
    const int wid = __builtin_amdgcn_readfirstlane(TIDX >> 6), hi = (TIDX & 63) >> 5;
    float l = 0.f;
    __syncthreads();
    b_issue_k(lds, c, wid, 0, 0); b_issue_k(lds, c, wid, 1, 1);
    int ks = 0, ks2 = 2;
    for (int kt = 0; kt < NT; ++kt) {
        if (kt + 1 < NT) B_WAITV(2); else B_WAITV(0);
        __builtin_amdgcn_s_barrier(); asm volatile("" ::: "memory");
        if (kt + 2 < NT) b_issue_k(lds, c, wid, kt + 2, ks2);
        float p[16];
        b_scores(lds, c, qf, ks, dh, kt, t, hi, slope2, Mb2, p, l);
        asm volatile("s_waitcnt lgkmcnt(0)" ::: "memory");
        ks = ks == B_NKS - 1 ? 0 : ks + 1; ks2 = ks2 == B_NKS - 1 ? 0 : ks2 + 1;
    }
    l += __shfl_xor(l, 32);
    return l;
}
#define SGB(mask, n) __builtin_amdgcn_sched_group_barrier((mask), (n), 0)
__device__ __forceinline__ float attnB_passPV(LAS unsigned char* lds, const BCtx& c, const bf16x8 (&qf)[8], f32x16 (&O)[4], float slope2, float Mb2, int dh) {
    const int t = c.t;
    constexpr int NT = SEQ / 64;
    const int lane = TIDX & 63, wid = __builtin_amdgcn_readfirstlane(TIDX >> 6), hi = lane >> 5;
    LAS unsigned char* pmine = lds + B_OFF_P + wid * 2048 + lane * 32;
    const LAS unsigned char* ptheirs = lds + B_OFF_P + (wid ^ 4) * 2048 + lane * 32;
    float l = 0.f;
    u32x4 w0, w1;
    __syncthreads();
    b_issue_k(lds, c, wid, 0, 0); b_issue_k(lds, c, wid, 1, 1); b_issue_v(lds, c, wid, 0, 0);
    B_WAITV(0);
    __builtin_amdgcn_s_barrier(); asm volatile("" ::: "memory");
    b_issue_k(lds, c, wid, 2, 2);
    {
        float p[16];
        b_scores(lds, c, qf, 0, dh, 0, t, hi, slope2, Mb2, p, l);
        w0.x = pk2(p[0], p[1]); w0.y = pk2(p[2], p[3]); w0.z = pk2(p[4], p[5]); w0.w = pk2(p[6], p[7]);
        w1.x = pk2(p[8], p[9]); w1.y = pk2(p[10], p[11]); w1.z = pk2(p[12], p[13]); w1.w = pk2(p[14], p[15]);
        *(LAS u32x4*)(pmine) = w0; *(LAS u32x4*)(pmine + 16) = w1;
    }
    int ks1 = 1, ks3 = 0;
#pragma unroll 1
    for (int kt = 0; kt < NT - 1; ++kt) {
        if (kt + 2 < NT) B_WAITV(2); else B_WAITV(0);
        asm volatile("s_waitcnt lgkmcnt(0)" ::: "memory");
        __builtin_amdgcn_s_barrier(); asm volatile("" ::: "memory");
        b_issue_v(lds, c, wid, kt + 1, (kt + 1) & 1);
        if (kt + 3 < NT) b_issue_k(lds, c, wid, kt + 3, ks3);
        const u32x4 t0 = *(const LAS u32x4*)(ptheirs + (kt & 1) * 16384), t1 = *(const LAS u32x4*)(ptheirs + (kt & 1) * 16384 + 16);
        const bf16x8 pp[4] = {__builtin_bit_cast(bf16x8, dh == 0 ? w0 : t0), __builtin_bit_cast(bf16x8, dh == 0 ? w1 : t1), __builtin_bit_cast(bf16x8, dh == 0 ? t0 : w0), __builtin_bit_cast(bf16x8, dh == 0 ? t1 : w1)};
        const LAS unsigned char* vb = lds + B_OFF_V + (kt & 1) * B_VT + dh * 16384 + c.vro;
        const LAS unsigned char* kb = lds + B_OFF_K + ks1 * B_KT + dh * 32 * 256 + c.kro;
        f32x16 sacc = {};
#pragma unroll
        for (int g = 0; g < 4; ++g) {
            const bf16x8 k0 = *(const LAS bf16x8*)(kb + (((2 * g) * 32) ^ c.kx2)), k1 = *(const LAS bf16x8*)(kb + (((2 * g + 1) * 32) ^ c.kx2));
            bf16x8 vf[4];
#pragma unroll
            for (int dt = 0; dt < 4; ++dt) vf[dt] = *(const LAS bf16x8*)(vb + dt * 4096 + ((32 * g) ^ c.vx2));
            sacc = MFMA32(k0, qf[2 * g], sacc);
            O[0] = MFMA32(vf[0], pp[g], O[0]); O[1] = MFMA32(vf[1], pp[g], O[1]);
            sacc = MFMA32(k1, qf[2 * g + 1], sacc);
            O[2] = MFMA32(vf[2], pp[g], O[2]); O[3] = MFMA32(vf[3], pp[g], O[3]);
        }
        SGB(0x100, 8);
#pragma unroll
        for (int g = 0; g < 4; ++g) { SGB(0x008, 3); SGB(0x100, 3); SGB(0x008, 3); SGB(0x100, 3); }
        __builtin_amdgcn_sched_barrier(0);
        {   const float tf = (float)(t - (64 * (kt + 1) + 32 * dh + 8 * hi));
            float p[16];
#pragma unroll
            for (int r = 0; r < 16; ++r) { p[r] = __builtin_amdgcn_exp2f(sacc[r] + (-slope2 * fabsf(tf - (float)(16 * (r >> 3) + (r & 7))) - Mb2)); l += p[r]; }
            w0.x = pk2(p[0], p[1]); w0.y = pk2(p[2], p[3]); w0.z = pk2(p[4], p[5]); w0.w = pk2(p[6], p[7]);
            w1.x = pk2(p[8], p[9]); w1.y = pk2(p[10], p[11]); w1.z = pk2(p[12], p[13]); w1.w = pk2(p[14], p[15]);
            *(LAS u32x4*)(pmine + ((kt + 1) & 1) * 16384) = w0; *(LAS u32x4*)(pmine + ((kt + 1) & 1) * 16384 + 16) = w1;
        }
        ks1 = ks1 == B_NKS - 1 ? 0 : ks1 + 1; ks3 = ks3 == B_NKS - 1 ? 0 : ks3 + 1;
    }
    {
        constexpr int kt = NT - 1;
        B_WAITV(0);
        asm volatile("s_waitcnt lgkmcnt(0)" ::: "memory");
        __builtin_amdgcn_s_barrier(); asm volatile("" ::: "memory");
        const u32x4 t0 = *(const LAS u32x4*)(ptheirs + (kt & 1) * 16384), t1 = *(const LAS u32x4*)(ptheirs + (kt & 1) * 16384 + 16);
        const bf16x8 pp[4] = {__builtin_bit_cast(bf16x8, dh == 0 ? w0 : t0), __builtin_bit_cast(bf16x8, dh == 0 ? w1 : t1), __builtin_bit_cast(bf16x8, dh == 0 ? t0 : w0), __builtin_bit_cast(bf16x8, dh == 0 ? t1 : w1)};
        const LAS unsigned char* vb = lds + B_OFF_V + (kt & 1) * B_VT + dh * 16384 + c.vro;
#pragma unroll
        for (int g = 0; g < 4; ++g) {
            bf16x8 vf[4];
#pragma unroll
            for (int dt = 0; dt < 4; ++dt) vf[dt] = *(const LAS bf16x8*)(vb + dt * 4096 + ((32 * g) ^ c.vx2));
#pragma unroll
            for (int dt = 0; dt < 4; ++dt) O[dt] = MFMA32(vf[dt], pp[g], O[dt]);
        }
    }
    l += __shfl_xor(l, 32);
    return l;
}
__device__ __forceinline__ BCtx b_make_ctx(const bf16* kbase  , const bf16* vbase  , int tbase) {
    int lane = TIDX & 63; asm volatile("" : "+v"(lane));
    const int wid = __builtin_amdgcn_readfirstlane(TIDX >> 6), r32 = lane & 31, hi = lane >> 5;
    BCtx c;
    const int kr = wid * 8 + (lane >> 4), kc = (lane & 15) ^ (kr & 15), vr = wid * 32 + (lane >> 3), vc = (lane & 7) ^ ((vr >> 1) & 7);
    c.kdelta = (kc & 4) ? -32 : 32; c.vdelta = (vc & 4) ? -32 : 32;
    const int krow = swap23(r32), kx = (krow & 15) * 16; c.kro = krow * 256 + ((hi * 16) ^ (kx & 16)); c.kx2 = kx & ~16;
    const int vx = ((r32 >> 1) & 7) * 16; c.vro = r32 * 128 + ((hi * 16) ^ (vx & 16)); c.vx2 = vx & ~16;
    c.ksrc = kbase + (size_t)kr * B_NQK + kc * 8; c.vsrc = vbase + (size_t)vr * MTOK + vc * 8; c.t = tbase + r32;
    return c;
}
__device__ __forceinline__ void attnB_phase(LAS unsigned char* lds, const bf16* qk, const bf16* Vt, bf16* ao, float* park  ,
                                            const float* gq, const float* gk, const float* lamv, const float* subln, const float lambda_init) {
    constexpr int LDQ = B_NQK;
    const int tid = TIDX, lane = tid & 63, wid = __builtin_amdgcn_readfirstlane(tid >> 6), r32 = lane & 31, hi = lane >> 5;
    const int qg = wid & 3, dh = wid >> 2;
    LAS float* xch = (LAS float*)(lds + B_OFF_XCH);
    const float SC2 = 0.08838834764831845f * LOG2E;
    const float mq = wave_max(fmaxf(fabsf(gq[lane]), fabsf(gq[lane + 64]))), mk = wave_max(fmaxf(fabsf(gk[lane]), fabsf(gk[lane + 64])));
    const float Mb2 = 128.0f * mq * mk * SC2;
    const float s01 = wave_sum(lamv[lane] * lamv[128 + lane] + lamv[64 + lane] * lamv[192 + lane]);
    const float s23 = wave_sum(lamv[256 + lane] * lamv[384 + lane] + lamv[320 + lane] * lamv[448 + lane]);
    const float lam = expf(s01) - expf(s23) + lambda_init;
    const int vcu = (gridDim.x & 7) == 0 ? (blockIdx.x & 7) * (gridDim.x >> 3) + (blockIdx.x >> 3) : blockIdx.x;
    for (int unit = vcu; unit < BATCH * 8 * 16; unit += gridDim.x) {
        const int qb = unit & 15, h = (unit >> 4) & 7, b = unit >> 7;
        const int rowbase = b * SEQ, tbase = qb * 128 + qg * 32;
        const float slope2 = exp2f(-(float)(h + 1)) * LOG2E;
        const bf16* k0 = qk + (size_t)rowbase * LDQ + 2048 + h * 256;
        const bf16* vb0 = Vt + (size_t)(h * 256) * MTOK + rowbase;
        const bf16* qrow = qk + (size_t)(rowbase + tbase) * LDQ + h * 256;
        f32x16 O[4];
        bf16x8 qf[8];
#define B_LANE(ln_) int ln_ = TIDX & 63; asm volatile("" : "+v"(ln_))
#define B_LOAD_Q(sub) do { B_LANE(ln_); const bf16* qp_ = qrow + (size_t)(ln_ & 31) * LDQ + (sub) * 128 + (ln_ >> 5) * 8; \
            _Pragma("unroll") for (int kk = 0; kk < 8; ++kk) qf[kk] = *(const bf16x8*)(qp_ + kk * 16); } while (0)
#pragma unroll
        for (int dt = 0; dt < 4; ++dt) O[dt] = (f32x16){};
        B_LOAD_Q(0);
        float l1 = attnB_passPV(lds, b_make_ctx(k0, vb0, tbase), qf, O, slope2, Mb2, dh);
        __syncthreads();
        { B_LANE(ln_); if (ln_ < 32) xch[wid * 32 + ln_] = l1; }
        __syncthreads();
        { B_LANE(ln_); l1 += xch[(wid ^ 4) * 32 + (ln_ & 31)]; }
        { B_LANE(ln_); f32x4* pk = (f32x4*)(park + ((size_t)blockIdx.x * 8 + wid) * 4096) + ln_; const float inv1 = 1.0f / l1;
#pragma unroll
          for (int dt = 0; dt < 4; ++dt)
#pragma unroll
              for (int q4 = 0; q4 < 4; ++q4) pk[(dt * 4 + q4) * 64] = (f32x4){O[dt][4 * q4] * inv1, O[dt][4 * q4 + 1] * inv1, O[dt][4 * q4 + 2] * inv1, O[dt][4 * q4 + 3] * inv1}; }
#pragma unroll
        for (int dt = 0; dt < 4; ++dt) O[dt] = (f32x16){};
        B_LOAD_Q(1);
        float l2 = attnB_passPV(lds, b_make_ctx(k0 + 128, vb0, tbase), qf, O, slope2, Mb2, dh);
        __syncthreads();
        { B_LANE(ln_); if (ln_ < 32) xch[wid * 32 + ln_] = l2; }
        __syncthreads();
        { B_LANE(ln_); l2 += xch[(wid ^ 4) * 32 + (ln_ & 31)]; }
        { B_LANE(ln_); const f32x4* pk = (const f32x4*)(park + ((size_t)blockIdx.x * 8 + wid) * 4096) + ln_; const float c2 = lam / l2;
          asm volatile("s_waitcnt vmcnt(0)" ::: "memory"); __builtin_amdgcn_fence(__ATOMIC_ACQUIRE, "agent");
#pragma unroll
          for (int dt = 0; dt < 4; ++dt)
#pragma unroll
              for (int q4 = 0; q4 < 4; ++q4) { const f32x4 p1 = pk[(dt * 4 + q4) * 64];
#pragma unroll
                  for (int e = 0; e < 4; ++e) O[dt][4 * q4 + e] = p1[e] - c2 * O[dt][4 * q4 + e]; } }
#undef B_LOAD_Q
        float ss = 0.f;
#pragma unroll
        for (int dt = 0; dt < 4; ++dt)
#pragma unroll
            for (int r = 0; r < 16; ++r) ss += O[dt][r] * O[dt][r];
        ss += __shfl_xor(ss, 32);
        B_LANE(ln);
        __syncthreads();
        if (ln < 32) xch[wid * 32 + ln] = ss;
        __syncthreads();
        ss += xch[(wid ^ 4) * 32 + (ln & 31)];
        const float rs = __builtin_amdgcn_rsqf(ss * (1.0f / 256.0f) + EPS) * (1.0f - lambda_init);
        const int hi2 = ln >> 5;
        bf16* op = ao + (size_t)(rowbase + tbase + (ln & 31)) * DM + h * 256 + dh * 128;
#pragma unroll
        for (int dt = 0; dt < 4; ++dt)
#pragma unroll
            for (int gp = 0; gp < 2; ++gp) { u32x2 pc[2];
#pragma unroll
                for (int e = 0; e < 2; ++e) { const int g4 = 2 * gp + e; const f32x4 sg = *(const f32x4*)(subln + dh * 128 + dt * 32 + 8 * g4 + 4 * hi2);
                    pc[e].x = pk2(O[dt][4 * g4] * rs * sg[0], O[dt][4 * g4 + 1] * rs * sg[1]); pc[e].y = pk2(O[dt][4 * g4 + 2] * rs * sg[2], O[dt][4 * g4 + 3] * rs * sg[3]); }
                const auto sx = __builtin_amdgcn_permlane32_swap(pc[0].x, pc[1].x, false, false), sy = __builtin_amdgcn_permlane32_swap(pc[0].y, pc[1].y, false, false);
                u32x4 w; w.x = sx[0]; w.y = sy[0]; w.z = sx[1]; w.w = sy[1];
                *(u32x4*)(op + dt * 32 + 16 * gp + 8 * hi2) = w; }
#undef B_LANE
    }
}

constexpr size_t MiB = 1u << 20;
constexpr size_t SZ_WQKVA = (size_t)2560 * 2048 * 2, SZ_WSQ = (size_t)2048 * 2048 * 2, SZ_WQKVB = (size_t)6144 * 2048 * 2, SZ_WIN = (size_t)11264 * 2048 * 2, SZ_WOUT = (size_t)2048 * 5632 * 2, SZ_WP = (size_t)2048 * 256 * 2;
constexpr size_t WS_WQKVA = 0, WS_WOA = WS_WQKVA + SZ_WQKVA, WS_WQKVB = WS_WOA + SZ_WSQ, WS_WOB = WS_WQKVB + SZ_WQKVB, WS_WIN0 = WS_WOB + SZ_WSQ, WS_WIN1 = WS_WIN0 + SZ_WIN,
                 WS_WOUT0 = WS_WIN1 + SZ_WIN, WS_WOUT1 = WS_WOUT0 + SZ_WOUT, WS_WG0 = WS_WOUT1 + SZ_WOUT, WS_WG1 = WS_WG0 + SZ_WSQ, WS_WP0 = WS_WG1 + SZ_WSQ, WS_WP1 = WS_WP0 + SZ_WP, WS_WEND = WS_WP1 + SZ_WP;
static_assert(WS_WEND == 200 * MiB, "weights");
constexpr size_t WS_HBA = 200 * MiB, WS_HBB = 264 * MiB, WS_PB0 = 328 * MiB, WS_PB1 = 336 * MiB, WS_QK = 344 * MiB, WS_VT = 472 * MiB, WS_ACT = 344 * MiB  ,
                 WS_AO = 536 * MiB, WS_PP = 600 * MiB, WS_PART = 664 * MiB, WS_SSQ = 672 * MiB, WS_BAR = 673 * MiB, WS_END = 674 * MiB;
constexpr int LDS_MISC_OFF = 156 * 1024 - 64;
static_assert(WS_ACT + (size_t)MTOK * DFF * 2 <= WS_AO, "act overlay");
enum { SQ_X = 0, SQ_1, SQ_2, SQ_3, SQ_4, SQ_5, SQ_PP0, SQ_PP1, SQ_N };

constexpr int LDS_BYTES = 156 * 1024;
static_assert(B_LDS_END <= LDS_BYTES, "attention B LDS");

struct Args {
    const float* in[21]; float* out; unsigned char* ws; int ph_lo, ph_hi;
};

constexpr int TR_WAVE_BYTES = 17408;
template <bool INTERLEAVE>
__device__ __forceinline__ void transpose_item(const float* W, int K, int N, bf16* WT, const float* gain, LAS unsigned* scr, int item, int lane) {
    const int nblk = N / 128, kb = item / nblk, nb = item % nblk, k0 = 64 * kb, n0 = 128 * nb;
    int r0 = n0;
    if (INTERLEAVE) { const int up = n0 >= DFF ? 1 : 0, j = n0 - up * DFF; r0 = (j >> 7) * 256 + up * 128 + (j & 127); }
    const int half = lane >> 5, nl = (lane & 31) * 4;
    const float* src = W + (size_t)(k0 + 2 * half) * N + n0 + nl;
#pragma unroll 4
    for (int i = 0; i < 16; ++i) {
        f32x4 a = __builtin_nontemporal_load((const f32x4*)(src + (size_t)(4 * i) * N)), b = __builtin_nontemporal_load((const f32x4*)(src + (size_t)(4 * i + 1) * N));
        if (gain) { const float g0 = gain[k0 + 4 * i + 2 * half], g1 = gain[k0 + 4 * i + 2 * half + 1]; a = a * g0; b = b * g1; }
        const int cw = 2 * i + half;
#pragma unroll
        for (int e = 0; e < 4; ++e) { const int r = nl + e; scr[r * 33 + (r >> 5) + cw] = pk2(a[e], b[e]); }
    }
    asm volatile("s_waitcnt lgkmcnt(0)" ::: "memory");
    const int ch = lane & 7;
#pragma unroll 4
    for (int j = 0; j < 16; ++j) { const int r = j * 8 + (lane >> 3); const LAS unsigned* sp = scr + r * 33 + (r >> 5) + ch * 4;
        u32x4 o; o.x = sp[0]; o.y = sp[1]; o.z = sp[2]; o.w = sp[3];
        *(u32x4*)(WT + (size_t)(r0 + r) * K + k0 + 8 * ch) = o; }
    asm volatile("s_waitcnt lgkmcnt(0)" ::: "memory");
}
template <bool INTERLEAVE>
__device__ __forceinline__ void transpose_job(const float* W, int K, int N, bf16* WT, const float* gain, LAS unsigned* scr, int gw, int NGW, int lane) {
    const int nitems = (K / 64) * (N / 128);
    for (int it = gw; it < nitems; it += NGW) transpose_item<INTERLEAVE>(W, K, N, WT, gain, scr, it, lane);
}

#ifndef REP_PRO
#define REP_PRO 1
#endif
#ifndef REP_ATTNA
#define REP_ATTNA 1
#endif
#ifndef REP_ATTNB
#define REP_ATTNB 1
#endif
#ifndef EXTRA_SYNCS
#define EXTRA_SYNCS 0
#endif
typedef const __attribute__((address_space(4))) Args* KArgs;
struct Ptrs {
    KArgs a;
    __device__ __forceinline__ explicit Ptrs(KArgs a_) : a(a_) {}
    __device__ __forceinline__ bf16* w(size_t off) const { return (bf16*)(a->ws + off); }
    __device__ __forceinline__ pg8::sq_t* ssq(int k) const { return (pg8::sq_t*)(a->ws + WS_SSQ) + (size_t)k * MTOK; }
};
#ifdef ONLY
constexpr int ONLYK = ONLY;
#else
constexpr int ONLYK = -1;
#endif
#define IN(k) (lo <= (k) && (k) < hi)
#define SEAM(k) do { if (IN(k) && IN((k) + 1)) { if (hi > 1000000) grid.sync(); else xcd_barrier(xbar); } } while (0)
typedef pg8::StaticOrder SO;

template <int L>
__device__ __forceinline__ void layer_body(KArgs a, LAS unsigned char* lds, cg::grid_group& grid, const XcdBarrier& xbar, const int lo, const int hi) {
    const Ptrs P_(a);
    const int G = gridDim.x, cu = blockIdx.x;
    constexpr int P = 1 + 6 * L;
    constexpr size_t WS_HB_IN = L == 0 ? WS_HBA : WS_HBB, WS_HB_MID = L == 0 ? WS_HBB : WS_HBA;
    constexpr int K_IN = L == 0 ? SQ_X : SQ_3, K_MIX = L == 0 ? SQ_1 : SQ_4, K_FFN = L == 0 ? SQ_2 : SQ_5, K_PP = L == 0 ? SQ_PP0 : SQ_PP1;
    constexpr size_t WS_WQKV = L == 0 ? WS_WQKVA : WS_WQKVB, WS_WO = L == 0 ? WS_WOA : WS_WOB, WS_WIN = L == 0 ? WS_WIN0 : WS_WIN1, WS_WOUT = L == 0 ? WS_WOUT0 : WS_WOUT1,
                     WS_WG = L == 0 ? WS_WG0 : WS_WG1, WS_WP = L == 0 ? WS_WP0 : WS_WP1, WS_PB = L == 0 ? WS_PB0 : WS_PB1;
    constexpr int nqk = L == 0 ? A_NQK : B_NQK, nv = L == 0 ? A_NV : B_NV;
    if (IN(P)) {
        if (ONLYK < 0 || ONLYK == 1) { pg8::Gemm g{P_.w(WS_HB_IN), P_.w(WS_WQKV), MTOK, nqk, 2048}; SO S; S.init(MTOK, nqk, G, cu); pg8::EpiQK E{P_.w(WS_QK), nqk, P_.ssq(K_IN), L == 0 ? a->in[5] : a->in[10], L == 0 ? a->in[6] : a->in[11], L == 0 ? 64 : 128, (L == 0 ? 0.125f : 0.08838834764831845f) * LOG2E, (LAS float*)(lds + 131072)};
          pg8::gemm_phase<pg8::EpiQK, SO, true, true>(lds, g, S, E); }
        if (ONLYK < 0 || ONLYK == 2) { pg8::Gemm g{P_.w(WS_WQKV) + (size_t)nqk * 2048, P_.w(WS_HB_IN), nv, MTOK, 2048}; SO S; S.init(nv, MTOK, G, (L == 0 && G == 256) ? ((cu + 64) & 255) : cu); pg8::EpiVt E{P_.w(WS_VT), MTOK, P_.ssq(K_IN)};
          pg8::gemm_phase<pg8::EpiVt, SO, true, true>(lds, g, S, E); }
        if (ONLYK < 0 || ONLYK == 3) { pg8::Gemm g{P_.w(WS_PB), P_.w(WS_WP), MTOK, 2048, 256}; SO S; if (L == 0 && G == 256) S.init(MTOK, 2048, 128, (cu >= 64 && cu < 192) ? cu - 64 : (1 << 20)); else S.init(MTOK, 2048, G, cu); pg8::EpiPP E{P_.w(WS_PP), P_.ssq(K_PP)};
          pg8::gemm_phase<pg8::EpiPP, SO, true, true>(lds, g, S, E); }
    }
    SEAM(P);
    if (IN(P + 1)) {
#ifdef DEBUG_COPYQ
        if (L == 0) { const bf16* q_ = P_.w(WS_QK); bf16* ao_ = P_.w(WS_AO);
            for (size_t i = (size_t)blockIdx.x * 512 + TIDX; i < (size_t)MTOK * DM; i += (size_t)gridDim.x * 512) { const size_t r_ = i / DM, c_ = i % DM;
                const float v_ = __uint_as_float((unsigned)q_[r_ * A_NQK + c_] << 16) + __uint_as_float((unsigned)q_[r_ * A_NQK + 2048 + (c_ & 255)] << 16);
                ao_[i] = (bf16)(__float_as_uint(v_) >> 16); } }
#endif
#ifndef SKIP_A
        if (L == 0) for (int rep = 0; rep < REP_ATTNA; ++rep) attnA_phase(lds, P_.w(WS_QK), P_.w(WS_VT), P_.w(WS_AO), a->in[5], a->in[6], a->in[7]);
#endif
#ifndef SKIP_B
        if (L == 1) for (int rep = 0; rep < REP_ATTNB; ++rep) attnB_phase(lds, P_.w(WS_QK), P_.w(WS_VT), P_.w(WS_AO), (float*)P_.w(WS_HB_MID), a->in[10], a->in[11], a->in[12], a->in[13], (float)(0.8 - 0.6 * 0.7408182206817179));
#endif
    }
    SEAM(P + 1);
    if (IN(P + 2)) {
        if (ONLYK < 0 || ONLYK == 4) { pg8::Gemm g{P_.w(WS_AO), P_.w(WS_WO), MTOK, 2048, 2048}; SO S; S.init(MTOK, 2048, G, cu);
          pg8::EpiRes E{P_.w(WS_HB_IN), P_.w(WS_HB_MID), P_.ssq(K_MIX)};
          pg8::gemm_phase<pg8::EpiRes, SO, true, true>(lds, g, S, E); }
    }
    SEAM(P + 2);
    if (IN(P + 3)) {
        if (ONLYK < 0 || ONLYK == 5) { pg8::Gemm g{P_.w(WS_HB_MID), P_.w(WS_WIN), MTOK, 2 * DFF, 2048}; SO S; S.init(MTOK, 2 * DFF, G, cu);
          pg8::EpiSwiGLU E{P_.w(WS_ACT), P_.ssq(K_MIX)};
          pg8::gemm_phase<pg8::EpiSwiGLU, SO, true, true>(lds, g, S, E); }
    }
    SEAM(P + 3);
    if (IN(P + 4)) {
        if (ONLYK < 0 || ONLYK == 4) { pg8::Gemm g{P_.w(WS_ACT), P_.w(WS_WOUT), MTOK, 2048, DFF}; SO S; S.init(MTOK, 2048, G, cu);
          pg8::EpiRes E{P_.w(WS_HB_MID), P_.w(WS_HB_IN), P_.ssq(K_FFN)};
          pg8::gemm_phase<pg8::EpiRes, SO, true, true>(lds, g, S, E); }
    }
    SEAM(P + 4);
    if (IN(P + 5)) {
        if (ONLYK < 0 || ONLYK == 6) { pg8::Gemm g{P_.w(WS_HB_IN), P_.w(WS_WG), MTOK, 2048, 2048}; SO S; S.init(MTOK, 2048, G, cu);
          pg8::EpiPLE E{P_.w(WS_HB_IN), L == 0 ? nullptr : a->out, L == 0 ? P_.w(WS_HB_MID) : nullptr, P_.ssq(SQ_3), P_.ssq(K_FFN), P_.ssq(K_PP), P_.w(WS_PP), a->in[18] + L * 2048};
          pg8::gemm_phase<pg8::EpiPLE, SO, true, true>(lds, g, S, E); }
    }
    if (L == 0) SEAM(P + 5);
}

__device__ __forceinline__ void prologue_phase(KArgs a, LAS unsigned char* lds) {
    const int tid = TIDX, lane = tid & 63, wave = __builtin_amdgcn_readfirstlane(tid >> 6);
    const int G = gridDim.x, cu = blockIdx.x;
    const Ptrs P_(a);
    LAS unsigned* scr = (LAS unsigned*)(lds + wave * TR_WAVE_BYTES);
    const int gw = cu * 8 + wave, NGW = G * 8;
    const float* attn_norm = a->in[2]; const float* ffn_norm = a->in[3];
    {   constexpr int I_QA = 32 * 20, I_SQ = 32 * 16, I_QB = 32 * 48, I_IN = 32 * 88, I_OUT = 88 * 16, I_P = 4 * 16;
        constexpr int E0 = I_QA, E1 = E0 + I_SQ, E2 = E1 + I_QB, E3 = E2 + I_SQ, E4 = E3 + 2 * I_IN, E5 = E4 + 2 * I_OUT, E6 = E5 + 2 * I_SQ, E7 = E6 + 2 * I_P;
        for (int it = gw; it < E7; it += NGW) {
            if (it < E0) transpose_item<false>(a->in[4], 2048, 2560, P_.w(WS_WQKVA), attn_norm, scr, it, lane);
            else if (it < E1) transpose_item<false>(a->in[8], 2048, 2048, P_.w(WS_WOA), nullptr, scr, it - E0, lane);
            else if (it < E2) transpose_item<false>(a->in[9], 2048, 6144, P_.w(WS_WQKVB), attn_norm + 2048, scr, it - E1, lane);
            else if (it < E3) transpose_item<false>(a->in[14], 2048, 2048, P_.w(WS_WOB), nullptr, scr, it - E2, lane);
            else if (it < E4) { const int i = (it - E3) / I_IN; transpose_item<true>(a->in[15] + (size_t)i * 2048 * 11264, 2048, 11264, P_.w(WS_WIN0 + i * SZ_WIN), ffn_norm + i * 2048, scr, (it - E3) % I_IN, lane); }
            else if (it < E5) { const int i = (it - E4) / I_OUT; transpose_item<false>(a->in[16] + (size_t)i * 5632 * 2048, 5632, 2048, P_.w(WS_WOUT0 + i * SZ_WOUT), nullptr, scr, (it - E4) % I_OUT, lane); }
            else if (it < E6) { const int i = (it - E5) / I_SQ; transpose_item<false>(a->in[20] + (size_t)i * 2048 * 2048, 2048, 2048, P_.w(WS_WG0 + i * SZ_WSQ), a->in[19] + i * 2048, scr, (it - E5) % I_SQ, lane); }
            else { const int i = (it - E6) / I_P; transpose_item<false>(a->in[17] + (size_t)i * 256 * 2048, 256, 2048, P_.w(WS_WP0 + i * SZ_WP), nullptr, scr, (it - E6) % I_P, lane); }
        }
    }
    const float* x = a->in[0]; bf16* hbA = P_.w(WS_HBA); pg8::sq_t* SSQ = P_.ssq(0);
    for (int m = gw; m < MTOK; m += NGW) {
        const f32x4* xr = (const f32x4*)(x + (size_t)m * DM) + lane; u32x2* o = (u32x2*)(hbA + (size_t)m * DM) + lane; float s = 0.f;
#pragma unroll
        for (int j = 0; j < 8; ++j) { const f32x4 v = __builtin_nontemporal_load(xr + 64 * j); s += pg8::sq4(v); u32x2 w; w.x = pk2(v[0], v[1]); w.y = pk2(v[2], v[3]); o[64 * j] = w; }
        s = wave_sum(s); if (lane == 0) SSQ[SQ_X * MTOK + m] = pg8::f2sq(s);
    }
    { const size_t n8 = (size_t)2 * MTOK * PLE / 8; bf16* pbb = P_.w(WS_PB0); const float* pin = a->in[1];
      for (size_t i = (size_t)cu * 512 + tid; i < n8; i += (size_t)G * 512) { const f32x4 v0 = __builtin_nontemporal_load((const f32x4*)(pin + i * 8)), v1 = __builtin_nontemporal_load((const f32x4*)(pin + i * 8 + 4)); *(u32x4*)(pbb + i * 8) = pg8::pack8(v0, v1); } }
    for (int i = cu * 512 + tid; i < (SQ_N - 1) * MTOK; i += G * 512) SSQ[MTOK + i] = 0ull;
}

__global__ void __launch_bounds__(512, 2) fwd_kernel(Args a_unused) {
    KArgs a = (KArgs)__builtin_amdgcn_kernarg_segment_ptr();
    extern __shared__ __attribute__((aligned(16))) unsigned char lds_raw[];
    LAS unsigned char* lds = (LAS unsigned char*)lds_raw;
    cg::grid_group grid = cg::this_grid();
    if ((threadIdx.x & 63) == 0) ((volatile LAS int*)(LDS_WTAB_OFF))[hw_wave_key()] = (int)(threadIdx.x >> 6);
    __syncthreads();
    const int lo = a->ph_lo, hi = a->ph_hi;
    volatile LAS unsigned* misc = (volatile LAS unsigned*)(lds + LDS_MISC_OFF);
    if (TIDX < 16) misc[TIDX] = 0u;
    __syncthreads();
    XcdBarrier xbar; xbar.bar = (unsigned*)(a->ws + WS_BAR); xbar.x = 0; xbar.st = misc;
    if (hi - lo > 1) xbar = xcd_barrier_post((unsigned*)(a->ws + WS_BAR), misc);
    if (IN(0)) { for (int rep = 0; rep < REP_PRO; ++rep) { prologue_phase(a, lds); __syncthreads(); } }
    for (int rep = 0; rep < EXTRA_SYNCS; ++rep) grid.sync();
    SEAM(0);
    layer_body<0>(a, lds, grid, xbar, lo, hi);
    layer_body<1>(a, lds, grid, xbar, lo, hi);
}
#undef IN
#undef SEAM

constexpr int N_PHASES = 13;
#ifndef N_LAUNCH_SPLIT
#define N_LAUNCH_SPLIT 0
#endif

extern "C" void kernel_launch(void* const* d_in, const int* in_sizes, int n_in, void* d_out, int out_size, void* d_ws, size_t ws_size, hipStream_t stream) {
    static int grid = 0;
    if (grid == 0) {
        if (n_in != 21 || out_size != MTOK * DM || ws_size < WS_END) { fprintf(stderr, "kernel_launch: unexpected shapes (n_in %d, out %d, ws %zu)\n", n_in, out_size, ws_size); grid = -1; return; }
        int dev = 0, cus = 0, per_cu = 0;
        hipGetDevice(&dev); hipDeviceGetAttribute(&cus, hipDeviceAttributeMultiprocessorCount, dev);
        if (hipFuncSetAttribute((const void*)fwd_kernel, hipFuncAttributeMaxDynamicSharedMemorySize, LDS_BYTES) != hipSuccess) { fprintf(stderr, "kernel_launch: hipFuncSetAttribute failed\n"); grid = -1; return; }
        if (hipOccupancyMaxActiveBlocksPerMultiprocessor(&per_cu, (const void*)fwd_kernel, 512, LDS_BYTES) != hipSuccess || per_cu < 1) { fprintf(stderr, "kernel_launch: occupancy query says %d\n", per_cu); per_cu = 1; }
        (void)hipGetLastError();
        grid = cus * per_cu;
        fprintf(stderr, "kernel_launch: grid %d (cus %d x %d)\n", grid, cus, per_cu);
    }
    if (grid < 0) return;
    Args a{};
    for (int i = 0; i < 21; ++i) a.in[i] = (const float*)d_in[i];
    a.out = (float*)d_out; a.ws = (unsigned char*)d_ws;
    if (hipMemsetAsync((char*)d_ws + WS_BAR, 0, 16384, stream) != hipSuccess) { fprintf(stderr, "kernel_launch: memset of the barrier words failed\n"); return; }
#if N_LAUNCH_SPLIT
    for (int ph = 0; ph < N_PHASES; ++ph) { a.ph_lo = ph; a.ph_hi = ph + 1; hipLaunchKernelGGL(fwd_kernel, dim3(grid), dim3(512), LDS_BYTES, stream, a); }
#else
    a.ph_lo = 0; a.ph_hi = N_PHASES;
    void* args[] = {&a};
    hipError_t e = hipLaunchCooperativeKernel((const void*)fwd_kernel, dim3(grid), dim3(512), args, LDS_BYTES, stream);
    if (e != hipSuccess) fprintf(stderr, "kernel_launch: cooperative launch failed: %s (grid %d)\n", hipGetErrorString(e), grid);
#endif
}
```
